# Optimizing an MI355X kernel written in HIP

```python
import math
import jax
import jax.numpy as jnp
from jax import lax
import numpy as np

D_MODEL = 2048
BATCH = 4
SEQ = 4096
DEPTH = 4
DEC_BATCH = 16
DEC_SEQ = 64
PAST_LEN = 4096

CHUNK = 64
D_CONV = D_MODEL // 2
D_RWKV = D_MODEL // 2
HEAD_DIM = 64
N_RWKV_HEADS = D_RWKV // HEAD_DIM
CONV_WIDTH = 3
DECAY_LORA = 64
AAA_LORA = 64
GATE_LORA = 128
D_FF = 4 * D_MODEL
RMS_EPS = 1e-6
GN_EPS = 64e-5
DECAY_SCALE = math.exp(-0.5)

OFF_CIN = 0
OFF_CB = OFF_CIN + D_CONV
OFF_CC = OFF_CB + D_CONV
OFF_R = OFF_CC + D_CONV
OFF_K = OFF_R + D_RWKV
OFF_V = OFF_K + D_RWKV
OFF_WL = OFF_V + D_RWKV
OFF_AL = OFF_WL + DECAY_LORA
OFF_GL = OFF_AL + AAA_LORA
OFF_GATE_CONV = OFF_GL + GATE_LORA
OFF_GATE_RWKV = OFF_GATE_CONV + D_MODEL
D_IN = OFF_GATE_RWKV + D_MODEL
D_SHIFT = OFF_GATE_CONV - OFF_R

kernel_name = "hybrid_shortconv_rwkv7_stream_step"


def rmsnorm(x, g):
    xf = x.astype(jnp.float32)
    out = xf * lax.rsqrt(jnp.mean(xf * xf, axis=-1, keepdims=True) + RMS_EPS) * g.astype(jnp.float32)
    return out.astype(x.dtype)


def wkv_scan(S0, r, w, k, kk, a, v):
    xs = tuple(jnp.moveaxis(t, 1, 0) for t in (r, w, k, kk, a, v))

    def step(S, inp):
        r_t, w_t, k_t, kk_t, a_t, v_t = inp
        sa = jnp.einsum('bhvk,bhk->bhv', S, kk_t)
        S = (S * w_t[:, :, None, :]
             - sa[..., None] * (kk_t * a_t)[:, :, None, :]
             + v_t[..., None] * k_t[:, :, None, :])
        y = jnp.einsum('bhvk,bhk->bhv', S, r_t)
        return S, y

    S_final, ys = lax.scan(step, S0, xs)
    return jnp.moveaxis(ys, 0, 1), S_final


def layer(x, conv_state, shift_state, wkv_state,
          norm1, w_in, mu_shift, conv_w, w0, w2, a0, a2, g2, k_k, k_a, r_k,
          ln_x_w, ln_x_b, w_out_conv, w_out_rwkv, w_o, norm2, w_up, w_down):
    Bsz, T, _ = x.shape
    h = rmsnorm(x, norm1)
    P = h @ w_in

    c_in = P[..., OFF_CIN:OFF_CB]
    c_b = P[..., OFF_CB:OFF_CC]
    c_c = P[..., OFF_CC:OFF_R]
    u = c_c * c_in
    u_pad = jnp.concatenate([conv_state.astype(u.dtype), u], axis=1)
    conv = sum(conv_w[j] * u_pad[:, j:j + T] for j in range(CONV_WIDTH))
    y_conv = (c_b * conv) @ w_out_conv
    new_conv = u_pad[:, T:]

    p_cur = P[..., OFF_R:OFF_GATE_CONV]
    p_first = shift_state.astype(h.dtype)[:, None, :] @ w_in[:, OFF_R:OFF_GATE_CONV]
    p_prev = jnp.concatenate([p_first, p_cur[:, :-1]], axis=1)
    p_mix = p_cur + mu_shift * (p_prev - p_cur)
    new_shift = h[:, -1]

    r = p_mix[..., OFF_R - OFF_R:OFF_K - OFF_R]
    k = p_mix[..., OFF_K - OFF_R:OFF_V - OFF_R]
    v = p_mix[..., OFF_V - OFF_R:OFF_WL - OFF_R]
    xw = p_mix[..., OFF_WL - OFF_R:OFF_AL - OFF_R]
    xa = p_mix[..., OFF_AL - OFF_R:OFF_GL - OFF_R]
    xg = p_mix[..., OFF_GL - OFF_R:]

    d = (w0 + jnp.tanh(xw) @ w2).astype(jnp.float32)
    w = jnp.exp(-DECAY_SCALE * jax.nn.sigmoid(d))
    a = jax.nn.sigmoid((a0 + xa @ a2).astype(jnp.float32))
    g = jax.nn.sigmoid(xg) @ g2

    heads = lambda t: t.astype(jnp.float32).reshape(Bsz, T, N_RWKV_HEADS, HEAD_DIM)
    rf, kf, vf, wf, af = heads(r), heads(k), heads(v), heads(w), heads(a)
    k_k_h = k_k.astype(jnp.float32).reshape(N_RWKV_HEADS, HEAD_DIM)
    k_a_h = k_a.astype(jnp.float32).reshape(N_RWKV_HEADS, HEAD_DIM)
    kk = kf * k_k_h
    kk = kk / jnp.maximum(jnp.sqrt(jnp.sum(kk * kk, axis=-1, keepdims=True)), 1e-12)
    kf = kf * (1.0 + (af - 1.0) * k_a_h)

    y, S_new = wkv_scan(wkv_state.astype(jnp.float32), rf, wf, kf, kk, af, vf)
    mean = jnp.mean(y, axis=-1, keepdims=True)
    var = jnp.mean(jnp.square(y - mean), axis=-1, keepdims=True)
    yn = ((y - mean) * lax.rsqrt(var + GN_EPS)).reshape(Bsz, T, D_RWKV)
    yn = yn * ln_x_w.astype(jnp.float32) + ln_x_b.astype(jnp.float32)
    bonus = jnp.sum(rf * kf * r_k.astype(jnp.float32), axis=-1, keepdims=True) * vf
    y_r = (yn + bonus.reshape(Bsz, T, D_RWKV)).astype(x.dtype) * g
    y_rwkv = y_r @ w_out_rwkv

    gate_c = jax.nn.sigmoid(P[..., OFF_GATE_CONV:OFF_GATE_RWKV])
    gate_r = jax.nn.sigmoid(P[..., OFF_GATE_RWKV:])
    x = x + (gate_c * y_conv + gate_r * y_rwkv) @ w_o

    h2 = rmsnorm(x, norm2)
    x = x + jnp.square(jax.nn.relu(h2 @ w_up)) @ w_down
    return x, new_conv, new_shift, S_new.astype(wkv_state.dtype)


def trunk(x, conv_states, shift_states, wkv_states,
          norm1, w_in, mu_shift, conv_w, w0, w2, a0, a2, g2, k_k, k_a, r_k,
          ln_x_w, ln_x_b, w_out_conv, w_out_rwkv, w_o, norm2, w_up, w_down, norm_f):
    convs, shifts, wkvs = [], [], []
    for l in range(DEPTH):
        x, c, s, S = layer(x, conv_states[l], shift_states[l], wkv_states[l],
                           norm1[l], w_in[l], mu_shift[l], conv_w[l], w0[l], w2[l], a0[l], a2[l],
                           g2[l], k_k[l], k_a[l], r_k[l], ln_x_w[l], ln_x_b[l], w_out_conv[l],
                           w_out_rwkv[l], w_o[l], norm2[l], w_up[l], w_down[l])
        convs.append(c)
        shifts.append(s)
        wkvs.append(S)
    return rmsnorm(x, norm_f), jnp.stack(convs), jnp.stack(shifts), jnp.stack(wkvs)


def setup_inputs(seed: int = 0) -> dict:
    key = jax.random.key(seed)
    ks = jax.random.split(key, 32)
    nrm = lambda k, shape, s: s * jax.random.normal(k, shape, jnp.float32)
    L = DEPTH
    return {
        "x_prompt": nrm(ks[0], (BATCH, SEQ, D_MODEL), 1.0),
        "x_sample": nrm(ks[1], (DEC_BATCH, DEC_SEQ, D_MODEL), 1.0),
        "cache_conv": nrm(ks[2], (L, DEC_BATCH, CONV_WIDTH - 1, D_CONV), 1.0),
        "state_shift": nrm(ks[3], (L, DEC_BATCH, D_MODEL), 1.0),
        "state_wkv": nrm(ks[4], (L, DEC_BATCH, N_RWKV_HEADS, HEAD_DIM, HEAD_DIM), 0.5),
        "norm1": 1.0 + nrm(ks[5], (L, D_MODEL), 0.02),
        "w_in": nrm(ks[6], (L, D_MODEL, D_IN), D_MODEL ** -0.5),
        "mu_shift": jax.random.uniform(ks[7], (L, D_SHIFT), jnp.float32),
        "conv_w": nrm(ks[8], (L, CONV_WIDTH, D_CONV), CONV_WIDTH ** -0.5),
        "w0": nrm(ks[9], (L, D_RWKV), 0.5),
        "w2": nrm(ks[10], (L, DECAY_LORA, D_RWKV), DECAY_LORA ** -0.5),
        "a0": nrm(ks[11], (L, D_RWKV), 0.1),
        "a2": nrm(ks[12], (L, AAA_LORA, D_RWKV), AAA_LORA ** -0.5),
        "g2": nrm(ks[13], (L, GATE_LORA, D_RWKV), GATE_LORA ** -0.5),
        "k_k": 0.85 + nrm(ks[14], (L, D_RWKV), 0.02),
        "k_a": 1.0 + nrm(ks[15], (L, D_RWKV), 0.02),
        "r_k": nrm(ks[16], (L, N_RWKV_HEADS, HEAD_DIM), 0.1),
        "ln_x_w": 1.0 + nrm(ks[17], (L, D_RWKV), 0.02),
        "ln_x_b": nrm(ks[18], (L, D_RWKV), 0.02),
        "w_out_conv": nrm(ks[19], (L, D_CONV, D_MODEL), D_CONV ** -0.5),
        "w_out_rwkv": nrm(ks[20], (L, D_RWKV, D_MODEL), D_RWKV ** -0.5),
        "w_o": nrm(ks[21], (L, D_MODEL, D_MODEL), D_MODEL ** -0.5),
        "norm2": 1.0 + nrm(ks[22], (L, D_MODEL), 0.02),
        "w_up": nrm(ks[23], (L, D_MODEL, D_FF), D_MODEL ** -0.5),
        "w_down": nrm(ks[24], (L, D_FF, D_MODEL), D_FF ** -0.5),
        "norm_f": 1.0 + nrm(ks[25], (D_MODEL,), 0.02),
    }


def reference(x_prompt, x_sample, cache_conv, state_shift, state_wkv,
              norm1, w_in, mu_shift, conv_w, w0, w2, a0, a2, g2, k_k, k_a, r_k,
              ln_x_w, ln_x_b, w_out_conv, w_out_rwkv, w_o, norm2, w_up, w_down, norm_f):
    dt = x_prompt.dtype
    zero_conv = jnp.zeros((DEPTH, BATCH, CONV_WIDTH - 1, D_CONV), dt)
    zero_shift = jnp.zeros((DEPTH, BATCH, D_MODEL), dt)
    zero_wkv = jnp.zeros((DEPTH, BATCH, N_RWKV_HEADS, HEAD_DIM, HEAD_DIM), state_wkv.dtype)
    y_prompt, conv_p, shift_p, wkv_p = trunk(
        x_prompt, zero_conv, zero_shift, zero_wkv,
        norm1, w_in, mu_shift, conv_w, w0, w2, a0, a2, g2, k_k, k_a, r_k,
        ln_x_w, ln_x_b, w_out_conv, w_out_rwkv, w_o, norm2, w_up, w_down, norm_f)
    y_sample, conv_s, shift_s, wkv_s = trunk(
        x_sample, cache_conv, state_shift, state_wkv,
        norm1, w_in, mu_shift, conv_w, w0, w2, a0, a2, g2, k_k, k_a, r_k,
        ln_x_w, ln_x_b, w_out_conv, w_out_rwkv, w_o, norm2, w_up, w_down, norm_f)
    return (y_prompt, y_sample, conv_p, shift_p, wkv_p, conv_s, shift_s, wkv_s)
```

```cpp
#include <hip/hip_runtime.h>
#include <cstdio>
#include <cstdint>

#ifndef MK_ONE_LAUNCH
#define MK_ONE_LAUNCH 1
#endif

__device__ __forceinline__ int lane_id_asm() { int v; asm volatile("v_mbcnt_lo_u32_b32 %0, -1, 0\n\tv_mbcnt_hi_u32_b32 %0, -1, %0" : "=v"(v)); return v; }

namespace pg8 {
#define PG8_LAS __attribute__((address_space(3)))
#define PG8_GAS __attribute__((address_space(1)))
typedef unsigned short bf16_t;
typedef short bf16x8 __attribute__((ext_vector_type(8)));
typedef float f32x4 __attribute__((ext_vector_type(4)));
typedef unsigned u32x4 __attribute__((ext_vector_type(4)));
typedef unsigned u32x2 __attribute__((ext_vector_type(2)));
constexpr int BM = 256, BK = 64, HALF = 128, HTB = HALF * BK * 2, STAGE_BYTES = 8 * HTB, NXCD = 8;

__host__ __device__ __forceinline__ int lds_byte(int r, int c) { const int st = (r >> 4) * 2 + (c >> 5), rr = r & 15, cc = c & 31, ob = rr * 64 + cc * 2; return st * 1024 + (ob ^ (((ob >> 9) & 1) << 5)); }
__host__ __device__ __forceinline__ void stage_rc(int b, int& R, int& C) { const int st = b / 1024, sb = b % 1024, swz = sb ^ (((sb >> 9) & 1) << 5); R = (st >> 1) * 16 + swz / 64; C = (st & 1) * 32 + (swz % 64) / 2; }
__host__ __device__ __forceinline__ int perm32(int rho) { const int n = rho >> 4, i = rho & 15; return 8 * (i >> 2) + 4 * n + (i & 3); }

struct Unit { int pm, pn, kt0, nkt, ks; };
struct Gemm { const bf16_t* A; const bf16_t* Bt; int M, N, K; };

struct Order {
    int nM, nN, nwg, G, c, nX, x0, nktf, sk, WGM, xoff;
    __device__ void init(int nM_, int nN_, int G_, int c_, int K_, int nX_ = 0, int x0_ = 0, int sk_ = 0, int wgm_ = 4, int xoff_ = 0) { WGM = wgm_; xoff = xoff_; nM = nM_; nN = nN_; nwg = nM * nN; G = G_; c = c_; nX = nX_; x0 = x0_; nktf = K_ / BK; sk = sk_; }
    __device__ bool next(int i, Unit& u) const {
        const long L = (long)i * G + c; if (L >= nwg + nX + xoff) return false;
        u.kt0 = 0; u.nkt = nktf; u.ks = -1;
        if (L >= nwg) { const int j = (int)(L - nwg) - xoff; if (j < 0) return false;
            if (sk) { const int uu = j / sk; u.ks = j % sk; u.pm = nM + uu / nN; u.pn = uu % nN; u.nkt = nktf / sk; u.kt0 = u.ks * u.nkt; }
            else { u.pm = nM; u.pn = x0 + j; }
            return true; }
        int wgid = (int)L; { const int q = nwg / NXCD, r = nwg % NXCD, xcd = wgid % NXCD, off = wgid / NXCD; wgid = (xcd < r ? xcd * (q + 1) : r * (q + 1) + (xcd - r) * q) + off; }
        const int nig = WGM * nN, gid = wgid / nig, fm = gid * WGM, gsz = (nM - fm) < WGM ? (nM - fm) : WGM;
        u.pm = fm + ((wgid % nig) % gsz); u.pn = (wgid % nig) / gsz; return true;
    }
    __device__ __forceinline__ void a_ready(const Unit&) const {}
    __device__ __forceinline__ void done(const Unit&) const {}
};

typedef float f32x2c __attribute__((ext_vector_type(2)));
typedef __bf16 bf16x2c __attribute__((ext_vector_type(2)));
__device__ __forceinline__ unsigned cvt_pk_bf16(float lo, float hi) { const f32x2c f = {lo, hi}; return __builtin_bit_cast(unsigned, __builtin_convertvector(f, bf16x2c)); }
__device__ __forceinline__ float bf_lo(unsigned w) { return __builtin_bit_cast(float, w << 16); }
__device__ __forceinline__ float bf_hi(unsigned w) { return __builtin_bit_cast(float, w & 0xffff0000u); }
__device__ __forceinline__ float sigmoidf_(float x) { return __builtin_amdgcn_rcpf(1.0f + __expf(-x)); }

struct EpiBf16 {
    static constexpr bool PERM = true, AFTER_DRAIN = false;
    PG8_GAS bf16_t* O; int ldc; int act;
    __device__ __forceinline__ void operator()(const f32x4 (&acc)[2][2][4][2], const Unit& u, int wr, int wc, int fr, int fq) const {
        { const int l_ = lane_id_asm(); fr = l_ & 15; fq = l_ >> 4; }
        const int row0 = u.pm * BM + wr * 64 + fr, col0 = u.pn * BM + wc * 32 + 8 * fq;
#pragma unroll
        for (int ai = 0; ai < 2; ++ai)
#pragma unroll
            for (int m = 0; m < 4; ++m) { PG8_GAS bf16_t* rowp = O + (size_t)(row0 + ai * HALF + m * 16) * ldc + col0;
#pragma unroll
                for (int bj = 0; bj < 2; ++bj) { f32x4 v0 = acc[ai][bj][m][0], v1 = acc[ai][bj][m][1];
                    if (act) {
#pragma unroll
                        for (int j = 0; j < 4; ++j) { const float a = fmaxf(v0[j], 0.f), b = fmaxf(v1[j], 0.f); v0[j] = a * a; v1[j] = b * b; } }
                    u32x4 w; w.x = cvt_pk_bf16(v0[0], v0[1]); w.y = cvt_pk_bf16(v0[2], v0[3]); w.z = cvt_pk_bf16(v1[0], v1[1]); w.w = cvt_pk_bf16(v1[2], v1[3]);
                    *(PG8_GAS u32x4*)(rowp + bj * HALF) = w; } }
    }
};
struct EpiRes {
    static constexpr bool PERM = true, AFTER_DRAIN = false;
    const PG8_GAS bf16_t* Xin; PG8_GAS bf16_t* Xout; int ldc; PG8_GAS bf16_t* SL; int row0s;
    __device__ __forceinline__ void operator()(const f32x4 (&acc)[2][2][4][2], const Unit& u, int wr, int wc, int fr, int fq) const {
        { const int l_ = lane_id_asm(); fr = l_ & 15; fq = l_ >> 4; }
        const int row0 = u.pm * BM + wr * 64 + fr, col0 = u.pn * BM + wc * 32 + 8 * fq;
        if (u.ks >= 0) {
            PG8_GAS bf16_t* base = SL + ((size_t)u.ks * 1024 + (row0 - row0s)) * ldc + col0;
#pragma unroll
            for (int ai = 0; ai < 2; ++ai)
#pragma unroll
                for (int m = 0; m < 4; ++m)
#pragma unroll
                    for (int bj = 0; bj < 2; ++bj) { const f32x4 v0 = acc[ai][bj][m][0], v1 = acc[ai][bj][m][1];
                        u32x4 w; w.x = cvt_pk_bf16(v0[0], v0[1]); w.y = cvt_pk_bf16(v0[2], v0[3]); w.z = cvt_pk_bf16(v1[0], v1[1]); w.w = cvt_pk_bf16(v1[2], v1[3]);
                        *(PG8_GAS u32x4*)(base + (size_t)(ai * HALF + m * 16) * ldc + bj * HALF) = w; }
            return;
        }
#pragma unroll
        for (int ai = 0; ai < 2; ++ai) {
            u32x4 xv[4][2];
#pragma unroll
            for (int m = 0; m < 4; ++m)
#pragma unroll
                for (int bj = 0; bj < 2; ++bj) xv[m][bj] = *(const PG8_GAS u32x4*)(Xin + (size_t)(row0 + ai * HALF + m * 16) * ldc + col0 + bj * HALF);
#pragma unroll
            for (int m = 0; m < 4; ++m)
#pragma unroll
                for (int bj = 0; bj < 2; ++bj) { const u32x4 x = xv[m][bj]; const f32x4 v0 = acc[ai][bj][m][0], v1 = acc[ai][bj][m][1];
                    u32x4 w; w.x = cvt_pk_bf16(bf_lo(x.x) + v0[0], bf_hi(x.x) + v0[1]); w.y = cvt_pk_bf16(bf_lo(x.y) + v0[2], bf_hi(x.y) + v0[3]);
                    w.z = cvt_pk_bf16(bf_lo(x.z) + v1[0], bf_hi(x.z) + v1[1]); w.w = cvt_pk_bf16(bf_lo(x.w) + v1[2], bf_hi(x.w) + v1[3]);
                    *(PG8_GAS u32x4*)(Xout + (size_t)(row0 + ai * HALF + m * 16) * ldc + col0 + bj * HALF) = w; }
            asm volatile("" ::: "memory"); }
    }
};
struct EpiLora {
    static constexpr bool PERM = false, AFTER_DRAIN = false;
    PG8_GAS float* WD; PG8_GAS bf16_t* AA; PG8_GAS bf16_t* GG; const PG8_GAS float* w0; const PG8_GAS float* a0;
    __device__ __forceinline__ void operator()(const f32x4 (&acc)[2][2][4][2], const Unit& u, int wr, int wc, int fr, int fq) const {
        { const int l_ = lane_id_asm(); fr = l_ & 15; fq = l_ >> 4; }
        const int t = u.pn >> 2, row0 = u.pm * BM + wr * 64 + fr, col0 = (u.pn & 3) * BM + wc * 32 + 4 * fq;
        if (t == 2) {
#pragma unroll
            for (int ai = 0; ai < 2; ++ai)
#pragma unroll
                for (int m = 0; m < 4; ++m) { PG8_GAS bf16_t* rp = GG + (size_t)(row0 + ai * HALF + m * 16) * 1024 + col0;
#pragma unroll
                    for (int bj = 0; bj < 2; ++bj)
#pragma unroll
                        for (int n = 0; n < 2; ++n) { const f32x4 v = acc[ai][bj][m][n]; u32x2 w; w.x = cvt_pk_bf16(v[0], v[1]); w.y = cvt_pk_bf16(v[2], v[3]); *(PG8_GAS u32x2*)(rp + bj * HALF + n * 16) = w; } }
        } else if (t == 1) {
#pragma unroll
            for (int bj = 0; bj < 2; ++bj)
#pragma unroll
                for (int n = 0; n < 2; ++n) { const f32x4 bv = *(const PG8_GAS f32x4*)(a0 + col0 + bj * HALF + n * 16);
#pragma unroll
                    for (int ai = 0; ai < 2; ++ai)
#pragma unroll
                        for (int m = 0; m < 4; ++m) { f32x4 v = acc[ai][bj][m][n] + bv;
#pragma unroll
                            for (int j = 0; j < 4; ++j) v[j] = sigmoidf_(v[j]);
                            u32x2 w; w.x = cvt_pk_bf16(v[0], v[1]); w.y = cvt_pk_bf16(v[2], v[3]);
                            *(PG8_GAS u32x2*)(AA + (size_t)(row0 + ai * HALF + m * 16) * 1024 + col0 + bj * HALF + n * 16) = w; } }
        } else {
#pragma unroll
            for (int bj = 0; bj < 2; ++bj)
#pragma unroll
                for (int n = 0; n < 2; ++n) { const f32x4 bv = *(const PG8_GAS f32x4*)(w0 + col0 + bj * HALF + n * 16);
#pragma unroll
                    for (int ai = 0; ai < 2; ++ai)
#pragma unroll
                        for (int m = 0; m < 4; ++m) { f32x4 v = acc[ai][bj][m][n] + bv;
#pragma unroll
                            for (int j = 0; j < 4; ++j) v[j] = -0.60653065971263342f * sigmoidf_(v[j]);
                            *(PG8_GAS f32x4*)(WD + (size_t)(row0 + ai * HALF + m * 16) * 1024 + col0 + bj * HALF + n * 16) = v; } }
        }
    }
};
struct EpiGate {
    static constexpr bool PERM = true, AFTER_DRAIN = false;
    PG8_GAS bf16_t* Z; const PG8_GAS bf16_t* Pg; int ldp; int add; PG8_GAS bf16_t* SL; int row0s;
    __device__ __forceinline__ void operator()(const f32x4 (&acc)[2][2][4][2], const Unit& u, int wr, int wc, int fr, int fq) const {
        { const int l_ = lane_id_asm(); fr = l_ & 15; fq = l_ >> 4; }
        const int row0 = u.pm * BM + wr * 64 + fr, col0 = u.pn * BM + wc * 32 + 8 * fq;
        if (u.ks >= 0) {
            PG8_GAS bf16_t* base = SL + ((size_t)u.ks * 1024 + (row0 - row0s)) * 2048 + col0;
#pragma unroll
            for (int ai = 0; ai < 2; ++ai)
#pragma unroll
                for (int m = 0; m < 4; ++m)
#pragma unroll
                    for (int bj = 0; bj < 2; ++bj) { const f32x4 v0 = acc[ai][bj][m][0], v1 = acc[ai][bj][m][1];
                        u32x4 w; w.x = cvt_pk_bf16(v0[0], v0[1]); w.y = cvt_pk_bf16(v0[2], v0[3]); w.z = cvt_pk_bf16(v1[0], v1[1]); w.w = cvt_pk_bf16(v1[2], v1[3]);
                        *(PG8_GAS u32x4*)(base + (size_t)(ai * HALF + m * 16) * 2048 + bj * HALF) = w; }
            return;
        }
#pragma unroll
        for (int ai = 0; ai < 2; ++ai) {
            u32x4 gw[4][2], zo[4][2];
#pragma unroll
            for (int m = 0; m < 4; ++m) { const int row = row0 + ai * HALF + m * 16;
#pragma unroll
                for (int bj = 0; bj < 2; ++bj) { gw[m][bj] = *(const PG8_GAS u32x4*)(Pg + (size_t)row * ldp + col0 + bj * HALF);
                    zo[m][bj] = add ? *(const PG8_GAS u32x4*)(Z + (size_t)row * 2048 + col0 + bj * HALF) : (u32x4){0u, 0u, 0u, 0u}; } }
#pragma unroll
            for (int m = 0; m < 4; ++m) { const int row = row0 + ai * HALF + m * 16;
#pragma unroll
                for (int bj = 0; bj < 2; ++bj) { const u32x4 g = gw[m][bj], z = zo[m][bj];
                    f32x4 v0 = acc[ai][bj][m][0], v1 = acc[ai][bj][m][1];
                    v0[0] = v0[0] * sigmoidf_(bf_lo(g.x)) + bf_lo(z.x); v0[1] = v0[1] * sigmoidf_(bf_hi(g.x)) + bf_hi(z.x); v0[2] = v0[2] * sigmoidf_(bf_lo(g.y)) + bf_lo(z.y); v0[3] = v0[3] * sigmoidf_(bf_hi(g.y)) + bf_hi(z.y);
                    v1[0] = v1[0] * sigmoidf_(bf_lo(g.z)) + bf_lo(z.z); v1[1] = v1[1] * sigmoidf_(bf_hi(g.z)) + bf_hi(z.z); v1[2] = v1[2] * sigmoidf_(bf_lo(g.w)) + bf_lo(z.w); v1[3] = v1[3] * sigmoidf_(bf_hi(g.w)) + bf_hi(z.w);
                    u32x4 w; w.x = cvt_pk_bf16(v0[0], v0[1]); w.y = cvt_pk_bf16(v0[2], v0[3]); w.z = cvt_pk_bf16(v1[0], v1[1]); w.w = cvt_pk_bf16(v1[2], v1[3]);
                    *(PG8_GAS u32x4*)(Z + (size_t)row * 2048 + col0 + bj * HALF) = w; } }
            asm volatile("" ::: "memory"); }
    }
};

template <class Epi, class Sched, bool ALIGN_EPI = false, bool SP2 = false>
__device__ __forceinline__ void gemm_phase(PG8_LAS unsigned char* lds, const Gemm g, const Sched& S, const Epi& E, int wid_in) {
    const int lane_ = lane_id_asm();
    const int wid = __builtin_amdgcn_readfirstlane(wid_in), lane = lane_, tid = wid * 64 + lane, wr = wid >> 2, wc = wid & 3, fr = lane & 15, fq = lane >> 4;
    const int K = g.K;
    unsigned voffA[2], voffB[2];
#pragma unroll
    for (int i = 0; i < 2; ++i) { int R, C; stage_rc(tid * 16 + i * 8192, R, C); const int Rb = Epi::PERM ? ((R & ~31) + perm32(R & 31)) : R;
        voffA[i] = (unsigned)(R * K + C) * 2u; voffB[i] = (unsigned)(Rb * K + C) * 2u; }
    const size_t kstep = (size_t)(BK * 2);
    const size_t hstep = (size_t)HALF * K * 2;
    const size_t tstep = 2 * hstep;
    const unsigned ldsw = (unsigned)wid * 1024u;
    const int aoff = lds_byte(wr * 64 + fr, fq * 8), boff = lds_byte(wc * 32 + fr, fq * 8);
#define PG8_SA(b, h) (((b) * 2 + (h)) * HTB)
#define PG8_SB(b, h) ((4 + (b) * 2 + (h)) * HTB)
#define PG8_STAGE(bufoff, gbase, voff) do { _Pragma("unroll") for (int _i = 0; _i < 2; ++_i) \
        __builtin_amdgcn_global_load_lds((const unsigned*)((const char*)(gbase) + (voff)[_i]), (PG8_LAS unsigned*)(lds + (bufoff) + ldsw + _i * 8192), 16, 0, 0); } while (0)
#define PG8_LDA(dst, b, h) do { _Pragma("unroll") for (int m = 0; m < 4; ++m) _Pragma("unroll") for (int k = 0; k < 2; ++k) dst[m][k] = *(const PG8_LAS bf16x8*)(lds + PG8_SA(b, h) + aoff + m * 2048 + k * 1024); } while (0)
#define PG8_LDB(dst, b, h) do { _Pragma("unroll") for (int n = 0; n < 2; ++n) _Pragma("unroll") for (int k = 0; k < 2; ++k) dst[n][k] = *(const PG8_LAS bf16x8*)(lds + PG8_SB(b, h) + boff + n * 2048 + k * 1024); } while (0)
#define PG8_MMA(ai, bj, At, Bt) do { __builtin_amdgcn_s_setprio(1); _Pragma("unroll") for (int m = 0; m < 4; ++m) _Pragma("unroll") for (int n = 0; n < 2; ++n) _Pragma("unroll") for (int k = 0; k < 2; ++k) \
        acc[ai][bj][m][n] = __builtin_amdgcn_mfma_f32_16x16x32_bf16(Bt[n][k], At[m][k], acc[ai][bj][m][n], 0, 0, 0); __builtin_amdgcn_s_setprio(0); } while (0)
#define PG8_WAIT_V(n) asm volatile("s_waitcnt vmcnt(" #n ")" ::: "memory")
#define PG8_WAIT_L(n) asm volatile("s_waitcnt lgkmcnt(" #n ")" ::: "memory")
#define PG8_BAR __builtin_amdgcn_s_barrier()
#define PG8_SCHED __builtin_amdgcn_sched_barrier(0)
    Unit cur, nxt; int ui = 0;
    if (!S.next(0, cur)) return;
    f32x4 acc[2][2][4][2];
#pragma unroll
    for (int a = 0; a < 2; ++a)
#pragma unroll
        for (int b = 0; b < 2; ++b)
#pragma unroll
            for (int m = 0; m < 4; ++m)
#pragma unroll
                for (int n = 0; n < 2; ++n) acc[a][b][m][n] = (f32x4){0.f, 0.f, 0.f, 0.f};
    bf16x8 At[4][2], B0[2][2], B1[2][2];
    const char* cA = (const char*)g.A + (size_t)cur.pm * tstep + (size_t)cur.kt0 * kstep; const char* cB = (const char*)g.Bt + (size_t)cur.pn * tstep + (size_t)cur.kt0 * kstep;
    S.a_ready(cur);
    if constexpr (SP2) {
        PG8_STAGE(PG8_SB(0, 0), cB, voffB); PG8_STAGE(PG8_SB(0, 1), cB + hstep, voffB); PG8_STAGE(PG8_SA(0, 0), cA, voffA); PG8_STAGE(PG8_SA(0, 1), cA + hstep, voffA);
        if (wr == 1) PG8_BAR;
        PG8_WAIT_V(2); PG8_BAR;
        PG8_STAGE(PG8_SB(1, 0), cB + kstep, voffB); PG8_STAGE(PG8_SA(1, 0), cA + kstep, voffA); PG8_STAGE(PG8_SB(1, 1), cB + hstep + kstep, voffB);
        PG8_WAIT_V(6); PG8_BAR;
    } else {
        PG8_STAGE(PG8_SB(0, 0), cB, voffB); PG8_STAGE(PG8_SA(0, 0), cA, voffA); PG8_STAGE(PG8_SB(0, 1), cB + hstep, voffB); PG8_STAGE(PG8_SA(0, 1), cA + hstep, voffA);
        if (wr == 1) PG8_BAR;
        PG8_WAIT_V(4); PG8_BAR;
        PG8_STAGE(PG8_SB(1, 0), cB + kstep, voffB); PG8_STAGE(PG8_SA(1, 0), cA + kstep, voffA); PG8_STAGE(PG8_SB(1, 1), cB + hstep + kstep, voffB);
        PG8_WAIT_V(6); PG8_BAR;
    }
    for (;;) {
        const bool has_next = S.next(ui + 1, nxt);
        const char* nA = has_next ? (const char*)g.A + (size_t)nxt.pm * tstep + (size_t)nxt.kt0 * kstep : cA; const char* nB = has_next ? (const char*)g.Bt + (size_t)nxt.pn * tstep + (size_t)nxt.kt0 * kstep : cB;
        const int nt = cur.nkt;
        for (int t = 0; t < nt; t += 2) {
            const bool last = (t == nt - 2);
            const char* a1 = cA + (size_t)(t + 1) * kstep;
            const char* a2 = last ? nA : cA + (size_t)(t + 2) * kstep; const char* b2 = last ? nB : cB + (size_t)(t + 2) * kstep;
            const char* a3 = a2 + kstep; const char* b3 = b2 + kstep;
            if (last && has_next) S.a_ready(nxt);
            if constexpr (SP2) {
            PG8_LDB(B0, 0, 0); PG8_LDB(B1, 0, 1); PG8_SCHED; PG8_LDA(At, 0, 0); PG8_STAGE(PG8_SA(1, 1), a1 + hstep, voffA);
            PG8_WAIT_V(8); PG8_WAIT_L(0); PG8_BAR; PG8_MMA(0, 0, At, B0); PG8_MMA(0, 1, At, B1); PG8_BAR; PG8_SCHED;
            PG8_LDA(At, 0, 1); PG8_STAGE(PG8_SB(0, 0), b2, voffB); PG8_STAGE(PG8_SB(0, 1), b2 + hstep, voffB); PG8_STAGE(PG8_SA(0, 0), a2, voffA);
            PG8_WAIT_V(8); PG8_WAIT_L(0); PG8_BAR; PG8_MMA(1, 0, At, B0); PG8_MMA(1, 1, At, B1); PG8_BAR; PG8_SCHED;
            PG8_LDB(B0, 1, 0); PG8_LDB(B1, 1, 1); PG8_SCHED; PG8_LDA(At, 1, 0); PG8_STAGE(PG8_SA(0, 1), a2 + hstep, voffA);
            PG8_WAIT_V(8); PG8_WAIT_L(0); PG8_BAR; PG8_MMA(0, 0, At, B0); PG8_MMA(0, 1, At, B1); PG8_BAR; PG8_SCHED;
            PG8_LDA(At, 1, 1); PG8_STAGE(PG8_SB(1, 0), b3, voffB); PG8_STAGE(PG8_SB(1, 1), b3 + hstep, voffB); PG8_STAGE(PG8_SA(1, 0), a3, voffA);
            PG8_WAIT_V(8); PG8_WAIT_L(0); PG8_BAR; PG8_MMA(1, 0, At, B0); PG8_MMA(1, 1, At, B1); PG8_BAR; PG8_SCHED;
            } else {
            PG8_LDB(B0, 0, 0); PG8_SCHED; PG8_LDA(At, 0, 0); PG8_STAGE(PG8_SA(1, 1), a1 + hstep, voffA);
            PG8_WAIT_L(8); PG8_BAR; PG8_WAIT_L(0); PG8_MMA(0, 0, At, B0); PG8_BAR; PG8_SCHED;
            PG8_LDB(B1, 0, 1); PG8_STAGE(PG8_SB(0, 0), b2, voffB);
            PG8_BAR; PG8_WAIT_L(0); PG8_MMA(0, 1, At, B1); PG8_BAR;
            PG8_LDA(At, 0, 1); PG8_STAGE(PG8_SA(0, 0), a2, voffA);
            PG8_BAR; PG8_WAIT_L(0); PG8_MMA(1, 0, At, B0); PG8_BAR; PG8_SCHED;
            PG8_STAGE(PG8_SB(0, 1), b2 + hstep, voffB);
            PG8_WAIT_V(6); PG8_BAR; PG8_MMA(1, 1, At, B1); PG8_BAR;
            PG8_LDB(B0, 1, 0); PG8_SCHED; PG8_LDA(At, 1, 0); PG8_STAGE(PG8_SA(0, 1), a2 + hstep, voffA);
            PG8_WAIT_L(8); PG8_BAR; PG8_WAIT_L(0); PG8_MMA(0, 0, At, B0); PG8_BAR; PG8_SCHED;
            PG8_LDB(B1, 1, 1); PG8_STAGE(PG8_SB(1, 0), b3, voffB);
            PG8_BAR; PG8_WAIT_L(0); PG8_MMA(0, 1, At, B1); PG8_BAR;
            PG8_LDA(At, 1, 1); PG8_STAGE(PG8_SA(1, 0), a3, voffA);
            PG8_BAR; PG8_WAIT_L(0); PG8_MMA(1, 0, At, B0); PG8_BAR; PG8_SCHED;
            PG8_STAGE(PG8_SB(1, 1), b3 + hstep, voffB);
            PG8_WAIT_V(6); PG8_BAR; PG8_MMA(1, 1, At, B1); PG8_BAR;
            }
        }
        if constexpr (ALIGN_EPI) { if (wr == 0) PG8_BAR; }
        E(acc, cur, wr, wc, fr, fq); S.done(cur);
        if (!has_next) break;
#pragma unroll
        for (int a = 0; a < 2; ++a)
#pragma unroll
            for (int b = 0; b < 2; ++b)
#pragma unroll
                for (int m = 0; m < 4; ++m)
#pragma unroll
                    for (int n = 0; n < 2; ++n) acc[a][b][m][n] = (f32x4){0.f, 0.f, 0.f, 0.f};
        cur = nxt; cA = nA; cB = nB; ++ui;
        if constexpr (ALIGN_EPI) { if (wr == 1) PG8_BAR; }
    }
    PG8_WAIT_V(0);
    if constexpr (!ALIGN_EPI) { if (wr == 0) PG8_BAR; }
    PG8_BAR;
#undef PG8_SA
#undef PG8_SB
#undef PG8_STAGE
#undef PG8_LDA
#undef PG8_LDB
#undef PG8_MMA
#undef PG8_WAIT_V
#undef PG8_WAIT_L
#undef PG8_BAR
#undef PG8_SCHED
}
}

constexpr int NWAVES = 8;
constexpr int D = 2048, DC = 1024, NH = 16, HD = 64, DIN = 10496, DFF = 8192, NL = 4;
constexpr int TP = 4096, TS = 64, BP = 4, BS = 16;
constexpr int MP = BP * TP, MS = BS * TS, M = MP + MS, MA = M + 256;
constexpr int OFF_CB = 1024, OFF_CC = 2048, OFF_R = 3072, OFF_GC = 6400, OFF_GR = 8448, DSHIFT = 3328;
constexpr float RMS_EPS = 1e-6f, GN_EPS = 64e-5f;
constexpr size_t O_YP = 0, O_YS = (size_t)MP * D, O_CONVP = O_YS + (size_t)MS * D, O_SHIFTP = O_CONVP + (size_t)NL * BP * 2 * DC, O_WKVP = O_SHIFTP + (size_t)NL * BP * D,
                 O_CONVS = O_WKVP + (size_t)NL * BP * NH * HD * HD, O_SHIFTS = O_CONVS + (size_t)NL * BS * 2 * DC, O_WKVS = O_SHIFTS + (size_t)NL * BS * D, O_END = O_WKVS + (size_t)NL * BS * NH * HD * HD;
constexpr size_t MiB = 1u << 20;
constexpr size_t WS_CTL = 0, CTL_ZERO_BYTES = 1 * MiB;
constexpr size_t SZ_WIN = (size_t)DIN * D * 2, SZ_WOC = (size_t)D * DC * 2, SZ_WO = (size_t)D * D * 2, SZ_WUP = (size_t)DFF * D * 2, SZ_WLORA = (size_t)3072 * 256 * 2;
constexpr size_t WS_WIN = 1 * MiB, WS_WOC = WS_WIN + NL * SZ_WIN, WS_WOR = WS_WOC + NL * SZ_WOC, WS_WO = WS_WOR + NL * SZ_WOC, WS_WUP = WS_WO + NL * SZ_WO, WS_WDN = WS_WUP + NL * SZ_WUP,
                 WS_WLORA = WS_WDN + NL * SZ_WUP;
constexpr size_t WS_HB = WS_WLORA + NL * SZ_WLORA;
constexpr size_t WS_PU = WS_HB + (size_t)MA * D * 2;
constexpr size_t WS_ACONV = WS_PU + (size_t)MA * DIN * 2;
constexpr size_t WS_ARWKV = WS_ACONV + (size_t)M * DC * 2;
constexpr size_t WS_RKV = WS_ARWKV + (size_t)M * DC * 2;
constexpr size_t WS_WD = WS_RKV + (size_t)M * 3072 * 2;
constexpr size_t WS_AA = WS_WD + (size_t)M * DC * 4;
constexpr size_t WS_GG = WS_AA + (size_t)M * DC * 4;
constexpr size_t WS_LL = WS_GG + (size_t)M * DC * 2;
constexpr size_t WS_END = WS_LL + (size_t)M * 256 * 2;
static_assert(WS_END <= 1375731712ull, "workspace map exceeds 4 x largest tensor");
static_assert((size_t)M * DFF * 2 <= (size_t)MA * DIN * 2 && (size_t)M * D * 2 <= (size_t)M * 3072 * 2, "overlays");
constexpr int CW_BAR = 4096;

constexpr int RING_OFF = 0, RING_BYTES = 131072;
constexpr int LDSCTL_OFF = RING_BYTES, MISC_OFF = LDSCTL_OFF + 320;
constexpr int LDS_BYTES = 147456;

#define GAS __attribute__((address_space(1)))
#define LAS __attribute__((address_space(3)))
typedef unsigned short bf16;
typedef unsigned v4u __attribute__((ext_vector_type(4)));
typedef unsigned v2u __attribute__((ext_vector_type(2)));
typedef float f32x4 __attribute__((ext_vector_type(4)));
typedef GAS unsigned gu32;
#define RLX_AGENT __ATOMIC_RELAXED, __HIP_MEMORY_SCOPE_AGENT
#define LDS_WAIT() asm volatile("s_waitcnt lgkmcnt(0)" ::: "memory")
#define VM_WAIT() asm volatile("s_waitcnt vmcnt(0)" ::: "memory")
__device__ __forceinline__ unsigned pk2(float lo, float hi) { return pg8::cvt_pk_bf16(lo, hi); }
__device__ __forceinline__ unsigned f2bf(float f) { return pk2(f, f) & 0xffffu; }
using pg8::bf_lo; using pg8::bf_hi; using pg8::sigmoidf_;

#define XB_TMO      128
#define XB_XCNT(j)  (256  + 64 * (j))
#define XB_XSUB(j)  (1280 + 64 * (j))
#define XB_XGEN(j)  (2304 + 64 * (j))
#define XB_TOP      3328
#define XB_TOPGEN   3392
#define XCD_BAR_WORDS 3456
#define XB_SPIN_CAP (1u << 18)
__device__ __forceinline__ unsigned xb_ld(unsigned* p)              { return __hip_atomic_load(p, __ATOMIC_RELAXED, __HIP_MEMORY_SCOPE_AGENT); }
__device__ __forceinline__ unsigned xb_add(unsigned* p, unsigned v) { return __hip_atomic_fetch_add(p, v, __ATOMIC_RELAXED, __HIP_MEMORY_SCOPE_AGENT); }
__device__ __forceinline__ unsigned xb_xcc_id() { return (unsigned)__builtin_amdgcn_s_getreg((3 << 11) | 20) & 0xFu; }
#define XB_SPIN(cond, bar) do { unsigned _sp = 0; while (cond) { __builtin_amdgcn_s_sleep(1); \
    if ((++_sp & 255u) == 0u) { if (xb_ld(&(bar)[XB_TMO])) break; if (_sp > XB_SPIN_CAP) { atomicAdd(&(bar)[XB_TMO], 1u); break; } } } } while (0)
struct XcdBarrier { unsigned* bar; unsigned x; volatile LAS unsigned* st; int wave; };
__device__ __forceinline__ bool xb_t0(int wave) { return wave == 0 && lane_id_asm() == 0; }
__device__ __forceinline__ XcdBarrier xcd_barrier_post(unsigned* bar, volatile LAS unsigned* st, int wave) {
    XcdBarrier b; b.bar = bar; b.x = xb_xcc_id(); b.st = st; b.wave = wave;
    if (xb_t0(wave)) (void)xb_add(&bar[XB_XCNT(b.x)], 1u);
    return b;
}
__device__ __forceinline__ void xcd_barrier_complete(unsigned* bar, unsigned x, unsigned& nloc, unsigned& nx) {
    const unsigned G = gridDim.x * gridDim.y * gridDim.z;
    unsigned sum, cnt, mine, sp = 0u;
    for (;;) {
        sum = 0u; cnt = 0u; mine = 0u;
#pragma unroll
        for (unsigned j = 0; j < 16; ++j) { const unsigned c = xb_ld(&bar[XB_XCNT(j)]); sum += c; cnt += (c > 0u) ? 1u : 0u; mine = (j == x) ? c : mine; }
        if (sum == G) break;
        __builtin_amdgcn_s_sleep(1);
        if ((++sp & 255u) == 0u) { if (xb_ld(&bar[XB_TMO])) break; if (sp > XB_SPIN_CAP) { atomicAdd(&bar[XB_TMO], 1u); break; } }
    }
    nloc = mine > 0u ? mine : 1u; nx = cnt > 0u ? cnt : 1u;
}
__device__ __forceinline__ void xcd_barrier(const XcdBarrier& b) {
    asm volatile("s_waitcnt vmcnt(0)" ::: "memory");
    __syncthreads();
    if (xb_t0(b.wave)) {
        unsigned* bar = b.bar; unsigned bx = b.x;
        asm volatile("" : "+s"(bar), "+s"(bx));
        __builtin_amdgcn_s_waitcnt(0);
        unsigned nloc = b.st[0], nx = b.st[1];
        if (nloc == 0u) { xcd_barrier_complete(bar, bx, nloc, nx); b.st[0] = nloc; b.st[1] = nx; }
        const unsigned old = xb_add(&bar[XB_XSUB(bx)], 1u);
        const unsigned gen = old / nloc;
        if (old + 1u == (gen + 1u) * nloc) {
            __builtin_amdgcn_fence(__ATOMIC_RELEASE, "agent");
            asm volatile("s_waitcnt vmcnt(0)" ::: "memory");
            const unsigned og = xb_add(&bar[XB_TOP], 1u);
            const unsigned tg = og / nx;
            if (og + 1u == (tg + 1u) * nx) xb_add(&bar[XB_TOPGEN], 1u);
            else XB_SPIN(xb_ld(&bar[XB_TOPGEN]) == tg, bar);
            __builtin_amdgcn_fence(__ATOMIC_ACQUIRE, "agent");
            xb_add(&bar[XB_XGEN(bx)], 1u);
            asm volatile("s_waitcnt vmcnt(0)" ::: "memory");
        } else {
            XB_SPIN(xb_ld(&bar[XB_XGEN(bx)]) == gen, bar);
            __builtin_amdgcn_fence(__ATOMIC_ACQUIRE, "agent");
            asm volatile("s_waitcnt vmcnt(0)" ::: "memory");
        }
    }
    __syncthreads();
}

struct Args { const float* in[26]; float* out; unsigned char* ws; int st_lo, st_hi; };
struct Frame {
    LAS unsigned char* lds;
    int wave, vcu, G;
    float* out; unsigned char* ws;
};
typedef const unsigned char __attribute__((address_space(4)))* kptr_t;
__device__ __forceinline__ kptr_t kargs() { kptr_t p = (kptr_t)__builtin_amdgcn_kernarg_segment_ptr(); asm volatile("" : "+s"(p)); return p; }
#define INP(k) (*(const float* const __attribute__((address_space(4)))*)(ka + 8 * (k)))
template <class T> __device__ __forceinline__ T* launder_s(T* p) { asm volatile("" : "+s"(p)); return p; }
template <class T> __device__ __forceinline__ LAS T* launder_l(LAS T* p) { asm volatile("" : "+v"(p)); return p; }
__device__ __forceinline__ int launder_si(int v) { asm volatile("" : "+s"(v)); return v; }
__device__ __forceinline__ int launder_v(int v) { asm volatile("" : "+v"(v)); return v; }
__device__ __forceinline__ void lds_barrier() { asm volatile("s_waitcnt lgkmcnt(0)" ::: "memory"); __builtin_amdgcn_s_barrier(); asm volatile("" ::: "memory"); }
template <int CTRL> __device__ __forceinline__ float dppf(float v) { return __builtin_bit_cast(float, __builtin_amdgcn_mov_dpp(__builtin_bit_cast(int, v), CTRL, 0xf, 0xf, true)); }
__device__ __forceinline__ float wave_sum(float v) {
    v += dppf<0xB1>(v); v += dppf<0x4E>(v); v += dppf<0x141>(v); v += dppf<0x140>(v);
    return (__builtin_bit_cast(float, __builtin_amdgcn_readlane(__builtin_bit_cast(int, v), 0)) + __builtin_bit_cast(float, __builtin_amdgcn_readlane(__builtin_bit_cast(int, v), 16))) +
           (__builtin_bit_cast(float, __builtin_amdgcn_readlane(__builtin_bit_cast(int, v), 32)) + __builtin_bit_cast(float, __builtin_amdgcn_readlane(__builtin_bit_cast(int, v), 48)));
}
__device__ __forceinline__ float sum8(float v) { v += dppf<0xB1>(v); v += dppf<0x4E>(v); v += dppf<0x141>(v); return v; }

__device__ __forceinline__ void p0_transpose_item(const float* W, int K, int N, bf16* WT, LAS float* scr, int item, int lane) {
    const int nblk = N / 32, kb = item / nblk, nb = item % nblk, k0 = 64 * kb, n0 = 32 * nb;
#pragma unroll 8
    for (int i = 0; i < 32; ++i) { const int kk = 2 * i + (lane >> 5); scr[kk * 33 + (lane & 31)] = ((const GAS float*)W)[(size_t)(k0 + kk) * N + n0 + (lane & 31)]; }
    LDS_WAIT(); asm volatile("" ::: "memory");
    const int c = lane & 7;
#pragma unroll
    for (int j = 0; j < 4; ++j) { const int n = (lane >> 3) + 8 * j; const LAS float* s = scr + (8 * c) * 33 + n;
        v4u o; o.x = pk2(s[0 * 33], s[1 * 33]); o.y = pk2(s[2 * 33], s[3 * 33]); o.z = pk2(s[4 * 33], s[5 * 33]); o.w = pk2(s[6 * 33], s[7 * 33]);
        *(GAS v4u*)(WT + (size_t)(n0 + n) * K + k0 + 8 * c) = o; }
    LDS_WAIT(); asm volatile("" ::: "memory");
}

__device__ __forceinline__ void phase_prologue(Frame& F) {
    const kptr_t ka = kargs(); const int lane = lane_id_asm(), tid = F.wave * 64 + lane; (void)tid; (void)ka;
    unsigned char* const ws_ = launder_s(F.ws); float* const out_ = launder_s(F.out); (void)ws_; (void)out_;
    LAS float* scr = (LAS float*)(F.lds + RING_OFF + F.wave * 16384);
    const int gw = F.vcu * NWAVES + F.wave, NGW = F.G * NWAVES;
    constexpr int I_IN = (D / 64) * (DIN / 32), I_OC = (DC / 64) * (D / 32), I_O = (D / 64) * (D / 32), I_UP = (D / 64) * (DFF / 32), I_DN = (DFF / 64) * (D / 32);
    constexpr int PER_L = I_IN + 2 * I_OC + I_O + I_UP + I_DN, NITEMS = NL * PER_L;
    for (int it = gw; it < NITEMS; it += NGW) {
        const int l = it / PER_L; int r = it % PER_L;
        if (r < I_IN) { p0_transpose_item(INP(6) + (size_t)l * D * DIN, D, DIN, (bf16*)(ws_ + WS_WIN + l * SZ_WIN), scr, r, lane); continue; } r -= I_IN;
        if (r < I_OC) { p0_transpose_item(INP(19) + (size_t)l * DC * D, DC, D, (bf16*)(ws_ + WS_WOC + l * SZ_WOC), scr, r, lane); continue; } r -= I_OC;
        if (r < I_OC) { p0_transpose_item(INP(20) + (size_t)l * DC * D, DC, D, (bf16*)(ws_ + WS_WOR + l * SZ_WOC), scr, r, lane); continue; } r -= I_OC;
        if (r < I_O) { p0_transpose_item(INP(21) + (size_t)l * D * D, D, D, (bf16*)(ws_ + WS_WO + l * SZ_WO), scr, r, lane); continue; } r -= I_O;
        if (r < I_UP) { p0_transpose_item(INP(23) + (size_t)l * D * DFF, D, DFF, (bf16*)(ws_ + WS_WUP + l * SZ_WUP), scr, r, lane); continue; } r -= I_UP;
        p0_transpose_item(INP(24) + (size_t)l * DFF * D, DFF, D, (bf16*)(ws_ + WS_WDN + l * SZ_WUP), scr, r, lane);
    }
    const int gt = (F.vcu * NWAVES + F.wave) * 64 + lane, NGT = NGW * 64;
    for (int it = gt; it < NL * 3072 * 32; it += NGT) {
        const int l = it / (3072 * 32), rr = it % (3072 * 32), n = rr >> 5, k0 = (rr & 31) * 8;
        float v[8];
#pragma unroll
        for (int j = 0; j < 8; ++j) { const int k = k0 + j; float x = 0.f;
            if (n < 1024) { if (k < 64) x = ((const GAS float*)INP(10))[((size_t)l * 64 + k) * 1024 + n]; }
            else if (n < 2048) { if (k >= 64 && k < 128) x = ((const GAS float*)INP(12))[((size_t)l * 64 + (k - 64)) * 1024 + (n - 1024)]; }
            else { if (k >= 128) x = ((const GAS float*)INP(13))[((size_t)l * 128 + (k - 128)) * 1024 + (n - 2048)]; }
            v[j] = x; }
        v4u o; o.x = pk2(v[0], v[1]); o.y = pk2(v[2], v[3]); o.z = pk2(v[4], v[5]); o.w = pk2(v[6], v[7]);
        *(GAS v4u*)((bf16*)(ws_ + WS_WLORA + l * SZ_WLORA) + (size_t)n * 256 + k0) = o;
    }
}

__device__ __forceinline__ void unpack8(const v4u w, float (&f)[8]) { f[0] = bf_lo(w.x); f[1] = bf_hi(w.x); f[2] = bf_lo(w.y); f[3] = bf_hi(w.y); f[4] = bf_lo(w.z); f[5] = bf_hi(w.z); f[6] = bf_lo(w.w); f[7] = bf_hi(w.w); }
__device__ __forceinline__ v4u pack8(const float (&f)[8]) { v4u o; o.x = pk2(f[0], f[1]); o.y = pk2(f[2], f[3]); o.z = pk2(f[4], f[5]); o.w = pk2(f[6], f[7]); return o; }
__device__ __forceinline__ void phase_norm(Frame& F, int l, int mode) {
    const kptr_t ka = kargs(); const int lane = lane_id_asm(), tid = F.wave * 64 + lane; (void)tid; (void)ka;
    unsigned char* const ws_ = launder_s(F.ws); float* const out_ = launder_s(F.out); (void)ws_; (void)out_;
    const int gw = F.vcu * NWAVES + F.wave, NGW = F.G * NWAVES;
    GAS bf16* XB = (GAS bf16*)out_; GAS bf16* XS = (GAS bf16*)(ws_ + WS_RKV); GAS bf16* HB = (GAS bf16*)(ws_ + WS_HB);
    const float* gain = (mode == 0) ? INP(5) + (size_t)l * D : (mode == 1) ? INP(22) + (size_t)l * D : INP(25);
    if (mode == 0 && gw < BS) {
        const int j = gw; GAS v2u* o8 = (GAS v2u*)(HB + (size_t)(M + j) * D) + lane;
#pragma unroll
        for (int q = 0; q < 8; ++q) { const f32x4 s = *((const GAS f32x4*)(INP(3) + ((size_t)l * BS + j) * D) + lane + 64 * q); v2u w; w.x = pk2(s.x, s.y); w.y = pk2(s.z, s.w); o8[64 * q] = w; }
    }
    f32x4 g[4][2];
#pragma unroll
    for (int q = 0; q < 4; ++q) { const GAS f32x4* gp = (const GAS f32x4*)(gain + q * 512 + lane * 8); g[q][0] = gp[0]; g[q][1] = gp[1]; }
    const bool from_in = (mode == 0 && l == 0);
    const GAS bf16* XR = (mode == 2) ? XS : XB;
    GAS bf16* XW = (mode == 1 && l == NL - 1) ? XS : XB;
    f32x4 nf[4][2]; v4u nb[4];
#define NORM_LOAD(mm) do { if (from_in) { const float* src_ = ((mm) < MP) ? INP(0) + (size_t)(mm) * D : INP(1) + (size_t)((mm) - MP) * D; \
            _Pragma("unroll") for (int q = 0; q < 4; ++q) { const GAS f32x4* p_ = (const GAS f32x4*)(src_ + q * 512 + lane * 8); nf[q][0] = p_[0]; nf[q][1] = p_[1]; } } \
        else { _Pragma("unroll") for (int q = 0; q < 4; ++q) nb[q] = *(const GAS v4u*)(XR + (size_t)(mm) * D + q * 512 + lane * 8); } } while (0)
    if (gw < M) NORM_LOAD(gw);
    for (int m = gw; m < M; m += NGW) {
        float v[4][8];
        if (from_in) {
#pragma unroll
            for (int q = 0; q < 4; ++q) { v[q][0] = nf[q][0].x; v[q][1] = nf[q][0].y; v[q][2] = nf[q][0].z; v[q][3] = nf[q][0].w; v[q][4] = nf[q][1].x; v[q][5] = nf[q][1].y; v[q][6] = nf[q][1].z; v[q][7] = nf[q][1].w; } }
        else {
#pragma unroll
            for (int q = 0; q < 4; ++q) unpack8(nb[q], v[q]); }
        if (m + NGW < M) NORM_LOAD(m + NGW);
        const bool slab = (m >= MP) && !from_in;
        if (slab) { const GAS bf16* SL = (const GAS bf16*)(ws_ + WS_WD) + (size_t)(m - MP) * D;
#pragma unroll
            for (int hq = 0; hq < 2; ++hq) {
                v4u sv[2][8];
#pragma unroll
                for (int q = 0; q < 2; ++q)
#pragma unroll
                    for (int k8 = 0; k8 < 8; ++k8) sv[q][k8] = *(const GAS v4u*)(SL + (size_t)k8 * MS * D + (2 * hq + q) * 512 + lane * 8);
#pragma unroll
                for (int q = 0; q < 2; ++q)
#pragma unroll
                    for (int k8 = 0; k8 < 8; ++k8) { float p[8]; unpack8(sv[q][k8], p);
#pragma unroll
                        for (int j = 0; j < 8; ++j) v[2 * hq + q][j] += p[j]; } } }
        if (from_in || (slab && mode != 2)) {
#pragma unroll
            for (int q = 0; q < 4; ++q) { const v4u w = pack8(v[q]); *(GAS v4u*)(XW + (size_t)m * D + q * 512 + lane * 8) = w; unpack8(w, v[q]); } }
        float s = 0.f;
#pragma unroll
        for (int q = 0; q < 4; ++q)
#pragma unroll
            for (int j = 0; j < 8; ++j) s += v[q][j] * v[q][j];
        const float rstd = __builtin_amdgcn_rsqf(wave_sum(s) * (1.f / D) + RMS_EPS);
#pragma unroll
        for (int q = 0; q < 4; ++q) { v[q][0] *= rstd * g[q][0].x; v[q][1] *= rstd * g[q][0].y; v[q][2] *= rstd * g[q][0].z; v[q][3] *= rstd * g[q][0].w; v[q][4] *= rstd * g[q][1].x; v[q][5] *= rstd * g[q][1].y; v[q][6] *= rstd * g[q][1].z; v[q][7] *= rstd * g[q][1].w; }
        if (mode == 2) {
#pragma unroll
            for (int q = 0; q < 4; ++q) { GAS f32x4* o = (GAS f32x4*)(out_ + (size_t)m * D + q * 512 + lane * 8); o[0] = (f32x4){v[q][0], v[q][1], v[q][2], v[q][3]}; o[1] = (f32x4){v[q][4], v[q][5], v[q][6], v[q][7]}; }
            continue; }
#pragma unroll
        for (int q = 0; q < 4; ++q) *(GAS v4u*)(HB + (size_t)m * D + q * 512 + lane * 8) = pack8(v[q]);
        if (mode == 0) {
            float* so = nullptr;
            if (m < MP) { if ((m & (TP - 1)) == TP - 1) so = out_ + O_SHIFTP + ((size_t)l * BP + (m >> 12)) * D; }
            else { const int ms = m - MP; if ((ms & (TS - 1)) == TS - 1) so = out_ + O_SHIFTS + ((size_t)l * BS + (ms >> 6)) * D; }
            if (so) {
#pragma unroll
                for (int q = 0; q < 4; ++q) { GAS f32x4* o = (GAS f32x4*)(so + q * 512 + lane * 8); o[0] = (f32x4){v[q][0], v[q][1], v[q][2], v[q][3]}; o[1] = (f32x4){v[q][4], v[q][5], v[q][6], v[q][7]}; } }
        }
    }
#undef NORM_LOAD
}

__device__ __forceinline__ void phase_mix(Frame& F, int l) {
    const kptr_t ka = kargs(); const int lane = lane_id_asm(), tid = F.wave * 64 + lane; (void)tid; (void)ka;
    unsigned char* const ws_ = launder_s(F.ws); float* const out_ = launder_s(F.out); (void)ws_; (void)out_;
    const int gw = F.vcu * NWAVES + F.wave, NGW = F.G * NWAVES;
    const GAS bf16* P = (const GAS bf16*)(ws_ + WS_PU);
    GAS bf16* ACONV = (GAS bf16*)(ws_ + WS_ACONV); GAS bf16* RKV = (GAS bf16*)(ws_ + WS_RKV); GAS bf16* LL = (GAS bf16*)(ws_ + WS_LL);
    const GAS float* mu = (const GAS float*)(INP(7) + (size_t)l * DSHIFT); const GAS float* cw = (const GAS float*)(INP(8) + (size_t)l * 3 * DC);
    constexpr int NITEM = (M / 8) * 9;
    for (int it = gw; it < NITEM; it += NGW) {
        const int tb = it / 9, ch = it - tb * 9, m0 = tb * 8;
        int b, t0, T; bool samp;
        if (m0 < MP) { b = m0 >> 12; t0 = m0 & (TP - 1); T = TP; samp = false; } else { const int ms = m0 - MP; b = ms >> 6; t0 = ms & (TS - 1); T = TS; samp = true; }
        const GAS bf16* p0 = P + (size_t)m0 * DIN;
        if (ch < 2) {
            const int c = ch * 512 + lane * 8;
            v4u rin[10], rcc[10], rcb[8];
#pragma unroll
            for (int i = 0; i < 10; ++i) if (i >= 2 || t0 > 0) { rin[i] = *(const GAS v4u*)(p0 + (ptrdiff_t)(i - 2) * DIN + c); rcc[i] = *(const GAS v4u*)(p0 + (ptrdiff_t)(i - 2) * DIN + OFF_CC + c); }
#pragma unroll
            for (int i = 0; i < 8; ++i) rcb[i] = *(const GAS v4u*)(p0 + (size_t)i * DIN + OFF_CB + c);
            float w0[8], w1[8], w2[8];
            { const f32x4 a0 = *(const GAS f32x4*)(cw + c), a1 = *(const GAS f32x4*)(cw + c + 4), b0 = *(const GAS f32x4*)(cw + DC + c), b1 = *(const GAS f32x4*)(cw + DC + c + 4), c0 = *(const GAS f32x4*)(cw + 2 * DC + c), c1 = *(const GAS f32x4*)(cw + 2 * DC + c + 4);
              w0[0] = a0.x; w0[1] = a0.y; w0[2] = a0.z; w0[3] = a0.w; w0[4] = a1.x; w0[5] = a1.y; w0[6] = a1.z; w0[7] = a1.w;
              w1[0] = b0.x; w1[1] = b0.y; w1[2] = b0.z; w1[3] = b0.w; w1[4] = b1.x; w1[5] = b1.y; w1[6] = b1.z; w1[7] = b1.w;
              w2[0] = c0.x; w2[1] = c0.y; w2[2] = c0.z; w2[3] = c0.w; w2[4] = c1.x; w2[5] = c1.y; w2[6] = c1.z; w2[7] = c1.w; }
            float um2[8], um1[8];
            if (t0 > 0) { float x[8], y[8]; unpack8(rin[0], x); unpack8(rcc[0], y);
#pragma unroll
                for (int j = 0; j < 8; ++j) um2[j] = x[j] * y[j];
                unpack8(rin[1], x); unpack8(rcc[1], y);
#pragma unroll
                for (int j = 0; j < 8; ++j) um1[j] = x[j] * y[j]; }
            else if (samp) { const GAS float* cst = (const GAS float*)(INP(2) + ((size_t)l * BS + b) * 2 * DC) + c;
#pragma unroll
                for (int j = 0; j < 8; ++j) { um2[j] = cst[j]; um1[j] = cst[DC + j]; } }
            else {
#pragma unroll
                for (int j = 0; j < 8; ++j) { um2[j] = 0.f; um1[j] = 0.f; } }
            GAS float* cout = (GAS float*)out_ + (samp ? O_CONVS + ((size_t)l * BS + b) * 2 * DC : O_CONVP + ((size_t)l * BP + b) * 2 * DC) + c;
            const bool lastb = (t0 + 8 == T);
#pragma unroll
            for (int i = 0; i < 8; ++i) { float x[8], y[8], cb[8], u[8], o[8]; unpack8(rin[i + 2], x); unpack8(rcc[i + 2], y); unpack8(rcb[i], cb);
#pragma unroll
                for (int j = 0; j < 8; ++j) { u[j] = x[j] * y[j]; o[j] = cb[j] * (w0[j] * um2[j] + w1[j] * um1[j] + w2[j] * u[j]); um2[j] = um1[j]; um1[j] = u[j]; }
                *(GAS v4u*)(ACONV + (size_t)(m0 + i) * DC + c) = pack8(o);
                if (lastb && i >= 6) {
#pragma unroll
                    for (int j = 0; j < 8; ++j) cout[(size_t)(i - 6) * DC + j] = u[j]; } }
        } else {
            const int cl = (ch - 2) * 512 + lane * 8;
            if (cl < DSHIFT) {
                v4u rc[9];
                const GAS bf16* pm1 = (t0 > 0) ? p0 - DIN : (samp ? P + (size_t)(M + b) * DIN : nullptr);
                if (pm1) rc[0] = *(const GAS v4u*)(pm1 + OFF_R + cl); else rc[0] = (v4u){0u, 0u, 0u, 0u};
#pragma unroll
                for (int i = 0; i < 8; ++i) rc[i + 1] = *(const GAS v4u*)(p0 + (size_t)i * DIN + OFF_R + cl);
                float muv[8];
                { const f32x4 a0 = *(const GAS f32x4*)(mu + cl), a1 = *(const GAS f32x4*)(mu + cl + 4); muv[0] = a0.x; muv[1] = a0.y; muv[2] = a0.z; muv[3] = a0.w; muv[4] = a1.x; muv[5] = a1.y; muv[6] = a1.z; muv[7] = a1.w; }
                float prv[8]; unpack8(rc[0], prv);
#pragma unroll
                for (int i = 0; i < 8; ++i) { float cur[8], mx[8]; unpack8(rc[i + 1], cur);
#pragma unroll
                    for (int j = 0; j < 8; ++j) { mx[j] = cur[j] + muv[j] * (prv[j] - cur[j]); prv[j] = cur[j]; }
                    if (ch < 8) *(GAS v4u*)(RKV + (size_t)(m0 + i) * 3072 + cl) = pack8(mx);
                    else { const int q = cl - 3072;
                        if (q < 64) {
#pragma unroll
                            for (int j = 0; j < 8; ++j) mx[j] = tanhf(mx[j]);
                        } else if (q >= 128) {
#pragma unroll
                            for (int j = 0; j < 8; ++j) mx[j] = sigmoidf_(mx[j]);
                        }
                        *(GAS v4u*)(LL + (size_t)(m0 + i) * 256 + q) = pack8(mx); } }
            }
        }
    }
}

__device__ __forceinline__ void phase_zred(Frame& F) {
    const int lane = lane_id_asm();
    unsigned char* const ws_ = launder_s(F.ws);
    const int gw = F.vcu * NWAVES + F.wave, NGW = F.G * NWAVES;
    const GAS bf16* P = (const GAS bf16*)(ws_ + WS_PU); GAS bf16* Z = (GAS bf16*)(ws_ + WS_RKV);
    const GAS bf16* SC_ = (const GAS bf16*)(ws_ + WS_WD); const GAS bf16* SR_ = (const GAS bf16*)(ws_ + WS_AA);
    for (int it = gw; it < MS * 4; it += NGW) {
        const int r = it >> 2, q = it & 3; const size_t m = (size_t)MP + r;
        { const int c = q * 512 + lane * 8;
            float gc[8], gr[8], sc[8], sr[8], o[8];
            const v4u gcw = *(const GAS v4u*)(P + m * DIN + OFF_GC + c), grw = *(const GAS v4u*)(P + m * DIN + OFF_GR + c);
            v4u ca[4], cb[4];
#pragma unroll
            for (int k4 = 0; k4 < 4; ++k4) { const size_t off = ((size_t)k4 * MS + r) * D + c; ca[k4] = *(const GAS v4u*)(SC_ + off); cb[k4] = *(const GAS v4u*)(SR_ + off); }
            unpack8(gcw, gc); unpack8(grw, gr);
#pragma unroll
            for (int j = 0; j < 8; ++j) { sc[j] = 0.f; sr[j] = 0.f; }
#pragma unroll
            for (int k4 = 0; k4 < 4; ++k4) { float pa[8], pb[8]; unpack8(ca[k4], pa); unpack8(cb[k4], pb);
#pragma unroll
                for (int j = 0; j < 8; ++j) { sc[j] += pa[j]; sr[j] += pb[j]; } }
#pragma unroll
            for (int j = 0; j < 8; ++j) o[j] = sigmoidf_(gc[j]) * sc[j] + sigmoidf_(gr[j]) * sr[j];
            *(GAS v4u*)(Z + m * D + c) = pack8(o); }
    }
}

constexpr int NCHUNK = BP * NH * (TP / 64) + BS * NH;
constexpr int CP = 72;
constexpr int L_QK = 0, L_RT = 9216, L_KT = 18432, L_BT = 27648, L_VT = 36864, L_KHT = 46080, L_BHT = 55296, L_LB = 64512, L_AKK = 73728, L_ARK = 82944, L_ARB = 92160,
              L_XF = 101376, XP = 68, L_LD = L_XF + 64 * XP * 4, L_WC = L_LD + 4096, L_GT = L_WC + 256, L_TB = L_GT + 2048, TBP = 40, L_END1 = L_TB + 64 * TBP * 2, ATP = 32;
static_assert(L_END1 <= RING_BYTES && 128 * ATP * 2 <= 9216, "scan1 LDS map");
typedef short bf16x8 __attribute__((ext_vector_type(8)));
__device__ __forceinline__ f32x4 mma16(bf16x8 a, bf16x8 b, f32x4 c) { return __builtin_amdgcn_mfma_f32_16x16x32_bf16(a, b, c, 0, 0, 0); }
__device__ __forceinline__ bf16x8 frag(const LAS bf16* base, int blk, int ks, int lane) { return *(const LAS bf16x8*)(base + (16 * blk + (lane & 15)) * CP + 32 * ks + 8 * (lane >> 4)); }
__device__ __forceinline__ v2u pack4(const f32x4 v) { v2u o; o.x = pk2(v[0], v[1]); o.y = pk2(v[2], v[3]); return o; }
__device__ __forceinline__ void chunk_coords(int cidx, int& m0, int& h) {
    if (cidx < BP * NH * 64) { const int b = cidx >> 10; h = (cidx >> 6) & 15; m0 = b * TP + (cidx & 63) * 64; }
    else { const int q = cidx - BP * NH * 64; h = q & 15; m0 = MP + (q >> 4) * TS; }
}

__device__ __forceinline__ void phase_scan1(Frame& F, int l) {
    const kptr_t ka = kargs(); const int lane0 = lane_id_asm(); (void)ka;
    unsigned char* const ws_ = launder_s(F.ws);
    LAS unsigned char* const B0 = F.lds + RING_OFF;
    LAS bf16* QK = launder_l((LAS bf16*)(B0 + L_QK)); LAS bf16* RT = launder_l((LAS bf16*)(B0 + L_RT)); LAS bf16* KT = launder_l((LAS bf16*)(B0 + L_KT)); LAS bf16* BT = KT + 64 * CP;
    LAS bf16* VT = launder_l((LAS bf16*)(B0 + L_VT)); LAS bf16* KHT = launder_l((LAS bf16*)(B0 + L_KHT)); LAS bf16* BHT = launder_l((LAS bf16*)(B0 + L_BHT));
    LAS bf16* LB = launder_l((LAS bf16*)(B0 + L_LB)); LAS bf16* AKK = launder_l((LAS bf16*)(B0 + L_AKK)); LAS bf16* ARK = launder_l((LAS bf16*)(B0 + L_ARK)); LAS bf16* ARB = launder_l((LAS bf16*)(B0 + L_ARB));
    LAS bf16* PT = KT; LAS bf16* U0T = BT;
    LAS float* XF = launder_l((LAS float*)(B0 + L_XF)); LAS float* LD = launder_l((LAS float*)(B0 + L_LD)); LAS float* WC = LD + 1024; LAS float* GT = WC + 64;
    LAS bf16* ACCT = AKK;
    LAS bf16* TBt = (LAS bf16*)(GT + 512);
    GAS bf16* RKV = (GAS bf16*)(ws_ + WS_RKV); GAS float* WD = (GAS float*)(ws_ + WS_WD); GAS bf16* AA = (GAS bf16*)(ws_ + WS_AA); GAS float* BON = (GAS float*)(ws_ + WS_LL);
    const GAS float* k_k = (const GAS float*)(INP(14) + (size_t)l * DC); const GAS float* k_a = (const GAS float*)(INP(15) + (size_t)l * DC); const GAS float* r_k = (const GAS float*)(INP(16) + (size_t)l * DC);
    const int w = F.wave, G = F.G;
    const int tm = w >> 1, tn0 = (w & 1) * 2;
#define STAGE_LANE const int lane = launder_v(lane0), fr = lane & 15, fq = lane >> 4, tid = w * 64 + lane; (void)fr; (void)fq; (void)tid
    { const int lane = launder_v(lane0); for (int i = w * 64 + lane; i < 64 * TBP * 2 / 4; i += NWAVES * 64) ((LAS unsigned*)TBt)[i] = 0u; }
    unsigned rvw[8], kvw[8], vvw[8], avw[8]; float lwv[8];
#define SCAN1_LOAD(ci) do { const int lane = launder_v(lane0); int m0_, h_; chunk_coords((ci), m0_, h_); \
        const GAS bf16* rp = RKV + (size_t)(m0_ + 8 * w) * 3072 + h_ * 64; const GAS float* wp = WD + (size_t)(m0_ + 8 * w) * DC + h_ * 64; const GAS bf16* ap = AA + (size_t)(m0_ + 8 * w) * DC + h_ * 64; \
        _Pragma("unroll") for (int i = 0; i < 8; ++i) { \
            rvw[i] = rp[i * 3072 + lane]; kvw[i] = rp[i * 3072 + 1024 + lane]; vvw[i] = rp[i * 3072 + 2048 + lane]; lwv[i] = wp[i * DC + lane]; avw[i] = ap[i * DC + lane]; } } while (0)
    for (int cidx = (int)blockIdx.x; cidx < NCHUNK; cidx += G) {
        int m0, h; chunk_coords(cidx, m0, h);
        if (cidx == (int)blockIdx.x) SCAN1_LOAD(cidx);
        float khv[8], bhv[8], rv[8], kv[8], vv[8], av[8];
#pragma unroll
        for (int i = 0; i < 8; ++i) { rv[i] = __builtin_bit_cast(float, rvw[i] << 16); kv[i] = __builtin_bit_cast(float, kvw[i] << 16); vv[i] = __builtin_bit_cast(float, vvw[i] << 16); av[i] = __builtin_bit_cast(float, avw[i] << 16); }
        {   STAGE_LANE; const int col = h * 64 + lane;
        float pre[8]; { float run = 0.f;
#pragma unroll
            for (int i = 0; i < 8; ++i) { run += lwv[i]; pre[i] = run; }
            GT[w * 64 + lane] = run; }
        lds_barrier();
        float offs = 0.f, tot = 0.f;
#pragma unroll
        for (int g = 0; g < 8; ++g) { const float x = GT[g * 64 + lane]; tot += x; offs += (g < w) ? x : 0.f; }
        const float kkc = k_k[col], kac = k_a[col], rkc = r_k[col]; float bonv = 0.f;
#pragma unroll
        for (int i = 0; i < 8; ++i) { const int t = 8 * w + i;
            const float kkr = kv[i] * kkc, ss = wave_sum(kkr * kkr), kk = kkr * __builtin_amdgcn_rsqf(fmaxf(ss, 1e-24f));
            const float kp = kv[i] * (1.0f + (av[i] - 1.0f) * kac), bb = kk * av[i];
            const float bon = wave_sum(rv[i] * kp * rkc);
            bonv = (lane == i) ? bon : bonv;
            const float cs = offs + pre[i], e_in = __expf(cs), e_ng = __builtin_amdgcn_rcpf(e_in), e_ex = __expf(cs - lwv[i]), e_h = __expf(tot - cs);
            QK[t * CP + lane] = (bf16)f2bf(kk * e_ex); RT[t * CP + lane] = (bf16)f2bf(rv[i] * e_in); KT[t * CP + lane] = (bf16)f2bf(kp * e_ng); BT[t * CP + lane] = (bf16)f2bf(bb * e_ng);
            khv[i] = kp * e_h; bhv[i] = bb * e_h; }
        { STAGE_LANE; *(LAS v4u*)(KHT + lane * CP + 8 * w) = pack8(khv); *(LAS v4u*)(BHT + lane * CP + 8 * w) = pack8(bhv); *(LAS v4u*)(VT + lane * CP + 8 * w) = pack8(vv); }
        if (w == 0) WC[lane] = __expf(tot);
        if (lane < 8) BON[(size_t)(m0 + 8 * w + lane) * NH + h] = bonv;
        }
        if (cidx + G < NCHUNK) SCAN1_LOAD(cidx + G);
        lds_barrier();
        {   STAGE_LANE; bf16x8 aq[2], ar[2];
#pragma unroll
            for (int ks = 0; ks < 2; ++ks) { aq[ks] = frag(QK, tm, ks, lane); ar[ks] = frag(RT, tm, ks, lane); }
#pragma unroll
            for (int q = 0; q < 2; ++q) { const int tn = tn0 + q;
                f32x4 aL = {0.f, 0.f, 0.f, 0.f}, aKK = aL, aRK = aL, aRB = aL;
#pragma unroll
                for (int ks = 0; ks < 2; ++ks) { const bf16x8 bb = frag(BT, tn, ks, lane), bk = frag(KT, tn, ks, lane);
                    aL = mma16(bb, aq[ks], aL); aKK = mma16(bk, aq[ks], aKK); aRK = mma16(bk, ar[ks], aRK); aRB = mma16(bb, ar[ks], aRB); }
                const int t = 16 * tm + fr, s0 = 16 * tn + 4 * fq;
                f32x4 mL, mKK, mRK, mRB, mD;
#pragma unroll
                for (int r = 0; r < 4; ++r) { const int sI = s0 + r; const bool lt = sI < t, le = sI <= t;
                    mKK[r] = lt ? aKK[r] : 0.f; mRK[r] = le ? aRK[r] : 0.f; mRB[r] = le ? aRB[r] : 0.f; mL[r] = (tn < tm) ? aL[r] : 0.f; mD[r] = lt ? aL[r] : 0.f; }
                *(LAS v2u*)(AKK + t * CP + s0) = pack4(mKK); *(LAS v2u*)(ARK + t * CP + s0) = pack4(mRK); *(LAS v2u*)(ARB + t * CP + s0) = pack4(mRB); *(LAS v2u*)(LB + t * CP + s0) = pack4(mL);
                if (tn == tm) *(LAS f32x4*)(LD + (tm * 16 + fr) * 16 + 4 * fq) = mD; }
        }
        lds_barrier();
        {   STAGE_LANE; bf16x8 a_[2];
#pragma unroll
            for (int ks = 0; ks < 2; ++ks) a_[ks] = frag(AKK, tm, ks, lane);
#pragma unroll
            for (int q = 0; q < 2; ++q) { const int tn = tn0 + q; f32x4 acc = {0.f, 0.f, 0.f, 0.f};
#pragma unroll
                for (int ks = 0; ks < 2; ++ks) acc = mma16(frag(VT, tn, ks, lane), a_[ks], acc);
                *(LAS f32x4*)(XF + (16 * tm + fr) * XP + 16 * tn + 4 * fq) = acc; }
            if (w == 0) { const int bb = lane >> 4, cc = lane & 15; float x[16];
                f32x4 Lr[16][4];
#pragma unroll
                for (int t = 1; t < 16; ++t)
#pragma unroll
                    for (int q4 = 0; q4 < (t + 3) / 4; ++q4) Lr[t][q4] = *(const LAS f32x4*)(LD + (bb * 16 + t) * 16 + 4 * q4);
#pragma unroll
                for (int t = 0; t < 16; ++t) { float acc = (t == cc) ? 1.f : 0.f;
#pragma unroll
                    for (int sI = 0; sI < t; ++sI) acc -= Lr[t][sI >> 2][sI & 3] * x[sI];
                    x[t] = acc; }
#pragma unroll
                for (int t = 0; t < 16; ++t) TBt[(bb * 16 + t) * TBP + cc] = (bf16)f2bf(x[t]); }
        }
        lds_barrier();
        {   STAGE_LANE; unsigned zz = 0u; asm volatile("" : "+v"(zz));
            for (int i = lane; i < 16 * CP * 2 / 16; i += 64) ((LAS v4u*)(PT + 16 * w * CP))[i] = (v4u){zz, zz, zz, zz};
            if (lane < 32) *(LAS v4u*)(ACCT + (16 * w + (lane >> 1)) * ATP + 16 + 8 * (lane & 1)) = (v4u){zz, zz, zz, zz}; asm volatile("" ::: "memory");
#pragma unroll
            for (int i = 0; i < 4; ++i) {
                f32x4 acc = {0.f, 0.f, 0.f, 0.f};
#pragma unroll
                for (int ks = 0; ks < (i + 1) / 2; ++ks) acc = mma16(frag(PT, w, ks, lane), frag(LB, i, ks, lane), acc);
                const int c0 = 16 * w + 4 * fq;
                f32x4 rhs;
                if (w < 4) { const v2u qv = *(const LAS v2u*)(QK + (16 * i + fr) * CP + c0); rhs = (f32x4){bf_lo(qv.x), bf_hi(qv.x), bf_lo(qv.y), bf_hi(qv.y)}; }
                else rhs = *(const LAS f32x4*)(XF + (16 * i + fr) * XP + c0 - 64);
                rhs = rhs - acc;
#pragma unroll
                for (int r = 0; r < 4; ++r) ACCT[(c0 + r) * ATP + fr] = (bf16)f2bf(rhs[r]);
                asm volatile("" ::: "memory");
                const bf16x8 ta = *(const LAS bf16x8*)(TBt + (16 * i + fr) * TBP + 8 * fq), tb = *(const LAS bf16x8*)(ACCT + (16 * w + fr) * ATP + 8 * fq);
                const f32x4 o = mma16(ta, tb, (f32x4){0.f, 0.f, 0.f, 0.f});
                *(LAS v2u*)(PT + (16 * w + fr) * CP + 16 * i + 4 * fq) = pack4(o);
                asm volatile("" ::: "memory");
            }
        }
        lds_barrier();
        {   STAGE_LANE; bf16x8 aRK[2], aRB[2], aPT[2], aVT[2], aU0[2];
#pragma unroll
            for (int ks = 0; ks < 2; ++ks) { aRK[ks] = frag(ARK, tm, ks, lane); aRB[ks] = frag(ARB, tm, ks, lane); aPT[ks] = frag(PT, tm, ks, lane); aVT[ks] = frag(VT, tm, ks, lane); aU0[ks] = frag(U0T, tm, ks, lane); }
#pragma unroll
            for (int q = 0; q < 2; ++q) { const int tn = tn0 + q; const f32x4 z = {0.f, 0.f, 0.f, 0.f};
                f32x4 y0a = z, y0b = z, qh = z, mc = z, nca = z, ncb = z;
#pragma unroll
                for (int ks = 0; ks < 2; ++ks) { const bf16x8 bVT = frag(VT, tn, ks, lane), bU0 = frag(U0T, tn, ks, lane), bPT = frag(PT, tn, ks, lane), bBH = frag(BHT, tn, ks, lane), bKH = frag(KHT, tn, ks, lane);
                    y0a = mma16(bVT, aRK[ks], y0a); y0b = mma16(bU0, aRB[ks], y0b); qh = mma16(bPT, aRB[ks], qh); mc = mma16(bBH, aPT[ks], mc); nca = mma16(bKH, aVT[ks], nca); ncb = mma16(bBH, aU0[ks], ncb); }
                const int row = 16 * tm + fr, c0 = 16 * tn + 4 * fq; const size_t mrow = (size_t)(m0 + row);
                *(GAS v2u*)(RKV + mrow * 3072 + h * 64 + c0) = pack4(y0a - y0b);
                { const v2u rt = *(const LAS v2u*)(RT + row * CP + c0); const f32x4 rtf = {bf_lo(rt.x), bf_hi(rt.x), bf_lo(rt.y), bf_hi(rt.y)};
                  *(GAS v2u*)(RKV + mrow * 3072 + 1024 + h * 64 + c0) = pack4(rtf - qh); }
                { const float wc = WC[row]; f32x4 d;
#pragma unroll
                  for (int r = 0; r < 4; ++r) d[r] = ((c0 + r == row) ? wc : 0.f) - mc[r];
                  *(GAS v2u*)((GAS bf16*)WD + mrow * 2048 + h * 128 + c0) = pack4(d); }
                *(GAS v2u*)(AA + mrow * DC + h * 64 + c0) = pack4(nca - ncb); }
        }
        lds_barrier();
    }
}

__device__ __forceinline__ void phase_scan2(Frame& F, int l) {
    const kptr_t ka = kargs(); const int lane = lane_id_asm(), tid = F.wave * 64 + lane; (void)ka;
    unsigned char* const ws_ = launder_s(F.ws); float* const out_ = launder_s(F.out);
    constexpr int MPI = 80, SPI = 68;
    LAS float* MB = launder_l((LAS float*)(F.lds + RING_OFF));
    LAS float* NB = MB + 2 * 64 * MPI;
    LAS float* SR = NB + 2 * 1024;
    const GAS bf16* WDb = (const GAS bf16*)(ws_ + WS_WD); const GAS bf16* AAb = (const GAS bf16*)(ws_ + WS_AA); GAS bf16* SC = (GAS bf16*)(ws_ + WS_HB);
    const int G = F.G, w = F.wave, fr = lane & 15, fq = lane >> 4;
    const int mrow = tid >> 3, mc8 = (tid & 7) * 8;
    constexpr int NPI = BP * NH * 4, NSI = BS * NH * 4;
    for (int item = (int)blockIdx.x; item < NPI + NSI; item += G) {
        const bool samp = item >= NPI; const int q = samp ? item - NPI : item, seq = q >> 2, rq = q & 3, b = seq >> 4, h = seq & 15;
        const int nch = samp ? 1 : TP / 64, cidx0 = samp ? BP * NH * 64 + seq : seq * 64, m0 = samp ? MP + b * TS : b * TP;
        {   const int r = tid >> 5, jp = tid & 31; float s0 = 0.f, s1 = 0.f;
            if (samp) { const GAS float* sp = (const GAS float*)(INP(4) + ((((size_t)l * BS + b) * NH + h) * HD + rq * 16 + r) * HD + 2 * jp); s0 = sp[0]; s1 = sp[1]; }
            SR[r * SPI + 2 * jp] = s0; SR[r * SPI + 2 * jp + 1] = s1; }
        v4u am, an, bm, bn, cm, cn, dm, dn;
#define S2_LOAD(st, M_, N_) do { if ((st) < nch) { const size_t mb_ = (size_t)(m0 + (st) * 64); \
            M_ = *(const GAS v4u*)(WDb + (mb_ + mrow) * 2048 + h * 128 + mc8); \
            if (tid < 128) N_ = *(const GAS v4u*)(AAb + (mb_ + rq * 16 + mrow) * DC + h * 64 + mc8); } } while (0)
#define S2_STORE(buf, M_, N_) do { LAS float* mp_ = MB + (buf) * 64 * MPI + mrow * MPI + mc8; \
            *(LAS f32x4*)mp_ = (f32x4){bf_lo(M_.x), bf_hi(M_.x), bf_lo(M_.y), bf_hi(M_.y)}; *(LAS f32x4*)(mp_ + 4) = (f32x4){bf_lo(M_.z), bf_hi(M_.z), bf_lo(M_.w), bf_hi(M_.w)}; \
            if (tid < 128) { LAS float* np_ = NB + (buf) * 1024 + mrow * 64 + mc8; \
                *(LAS f32x4*)np_ = (f32x4){bf_lo(N_.x), bf_hi(N_.x), bf_lo(N_.y), bf_hi(N_.y)}; *(LAS f32x4*)(np_ + 4) = (f32x4){bf_lo(N_.z), bf_hi(N_.z), bf_lo(N_.w), bf_hi(N_.w)}; } } while (0)
        S2_LOAD(0, am, an); S2_LOAD(1, bm, bn); S2_LOAD(2, cm, cn); S2_LOAD(3, dm, dn);
        S2_STORE(0, am, an);
        S2_LOAD(4, am, an);
        lds_barrier();
        f32x4 sD;
#pragma unroll
        for (int r = 0; r < 4; ++r) sD[r] = (w < 4) ? SR[(4 * fq + r) * SPI + 16 * w + fr] : 0.f;
#define S2_STEP(c, M_, N_) do { \
            if ((c) + 1 < nch) S2_STORE(((c) + 1) & 1, M_, N_); \
            S2_LOAD((c) + 5, M_, N_); \
            if (w < 4) { GAS bf16* scp = SC + ((size_t)(cidx0 + (c)) * 64 + rq * 16 + 4 * fq) * 64 + 16 * w + fr; \
                _Pragma("unroll") for (int r = 0; r < 4; ++r) scp[r * 64] = (bf16)f2bf(sD[r]); \
                const LAS float* Mc = MB + ((c) & 1) * 64 * MPI; const LAS float* Nc = NB + ((c) & 1) * 1024; \
                f32x4 acc; _Pragma("unroll") for (int r = 0; r < 4; ++r) acc[r] = Nc[(4 * fq + r) * 64 + 16 * w + fr]; \
                _Pragma("unroll") for (int kk = 0; kk < 16; ++kk) acc = __builtin_amdgcn_mfma_f32_16x16x4f32(SR[fr * SPI + 4 * kk + fq], Mc[(4 * kk + fq) * MPI + 16 * w + fr], acc, 0, 0, 0); \
                sD = acc; } \
            lds_barrier(); \
            if (w < 4) { _Pragma("unroll") for (int r = 0; r < 4; ++r) SR[(4 * fq + r) * SPI + 16 * w + fr] = sD[r]; } \
            lds_barrier(); } while (0)
        for (int c = 0; c < nch; c += 4) {
            S2_STEP(c, bm, bn); if (c + 1 >= nch) break;
            S2_STEP(c + 1, cm, cn); if (c + 2 >= nch) break;
            S2_STEP(c + 2, dm, dn); if (c + 3 >= nch) break;
            S2_STEP(c + 3, am, an);
        }
#undef S2_STEP
#undef S2_LOAD
#undef S2_STORE
        if (w < 4) { GAS float* so = (GAS float*)out_ + (samp ? O_WKVS + ((((size_t)l * BS + b) * NH + h) * HD + rq * 16 + 4 * fq) * HD : O_WKVP + ((((size_t)l * BP + b) * NH + h) * HD + rq * 16 + 4 * fq) * HD) + 16 * w + fr;
#pragma unroll
            for (int r = 0; r < 4; ++r) so[r * 64] = sD[r]; }
    }
}

__device__ __forceinline__ void phase_scan3(Frame& F, int l) {
    const kptr_t ka = kargs(); const int lane = lane_id_asm(), tid = F.wave * 64 + lane; (void)ka;
    unsigned char* const ws_ = launder_s(F.ws);
    LAS bf16* QH = launder_l((LAS bf16*)(F.lds + RING_OFF)); LAS bf16* SCB = QH + 64 * CP; LAS float* YF = (LAS float*)(QH + 2 * 64 * CP); constexpr int YP = 68;
    const GAS bf16* RKV = (const GAS bf16*)(ws_ + WS_RKV); const GAS bf16* SC = (const GAS bf16*)(ws_ + WS_HB); const GAS bf16* GG = (const GAS bf16*)(ws_ + WS_GG); const GAS float* BON = (const GAS float*)(ws_ + WS_LL);
    GAS bf16* ARWKV = (GAS bf16*)(ws_ + WS_ARWKV);
    const GAS float* lnw = (const GAS float*)(INP(17) + (size_t)l * DC); const GAS float* lnb = (const GAS float*)(INP(18) + (size_t)l * DC);
    const int w = F.wave, G = F.G, tok = tid >> 3, sg = tid & 7, tm = w >> 1, tn0 = (w & 1) * 2, fr = lane & 15, fq = lane >> 4;
    v4u pqh, psc, py0, pv, pg; float pbon;
#define S3_LOAD(ci) do { int m0_, h_; chunk_coords((ci), m0_, h_); const size_t m_ = (size_t)(m0_ + tok); const int col_ = h_ * 64 + sg * 8; \
        pqh = *(const GAS v4u*)(RKV + m_ * 3072 + 1024 + col_); psc = *(const GAS v4u*)(SC + ((size_t)(ci) * 64 + tok) * 64 + sg * 8); \
        py0 = *(const GAS v4u*)(RKV + m_ * 3072 + col_); pv = *(const GAS v4u*)(RKV + m_ * 3072 + 2048 + col_); pg = *(const GAS v4u*)(GG + m_ * DC + col_); pbon = BON[m_ * NH + h_]; } while (0)
    if ((int)blockIdx.x < NCHUNK) S3_LOAD((int)blockIdx.x);
    for (int cidx = (int)blockIdx.x; cidx < NCHUNK; cidx += G) {
        int m0, h; chunk_coords(cidx, m0, h);
        const size_t m = (size_t)(m0 + tok); const int col = h * 64 + sg * 8;
        *(LAS v4u*)(QH + tok * CP + sg * 8) = pqh; *(LAS v4u*)(SCB + tok * CP + sg * 8) = psc;
        const v4u y0w = py0, vw = pv, gw = pg; const float bon = pbon;
        lds_barrier();
        if (cidx + G < NCHUNK) S3_LOAD(cidx + G);
        {   bf16x8 a_[2];
#pragma unroll
            for (int ks = 0; ks < 2; ++ks) a_[ks] = frag(QH, tm, ks, lane);
#pragma unroll
            for (int q = 0; q < 2; ++q) { const int tn = tn0 + q; f32x4 acc = {0.f, 0.f, 0.f, 0.f};
#pragma unroll
                for (int ks = 0; ks < 2; ++ks) acc = mma16(frag(SCB, tn, ks, lane), a_[ks], acc);
                *(LAS f32x4*)(YF + (16 * tm + fr) * YP + 16 * tn + 4 * fq) = acc; }
        }
        lds_barrier();
        {   float y[8], y0[8], vv[8], g[8], ov[8]; unpack8(y0w, y0); unpack8(vw, vv); unpack8(gw, g);
            const f32x4 ya = *(const LAS f32x4*)(YF + tok * YP + sg * 8), yb = *(const LAS f32x4*)(YF + tok * YP + sg * 8 + 4);
            y[0] = ya[0] + y0[0]; y[1] = ya[1] + y0[1]; y[2] = ya[2] + y0[2]; y[3] = ya[3] + y0[3]; y[4] = yb[0] + y0[4]; y[5] = yb[1] + y0[5]; y[6] = yb[2] + y0[6]; y[7] = yb[3] + y0[7];
            float s_ = 0.f;
#pragma unroll
            for (int j = 0; j < 8; ++j) s_ += y[j];
            const float mean = sum8(s_) * (1.f / 64.f); float qv = 0.f;
#pragma unroll
            for (int j = 0; j < 8; ++j) { y[j] -= mean; qv += y[j] * y[j]; }
            const float rstd = __builtin_amdgcn_rsqf(sum8(qv) * (1.f / 64.f) + GN_EPS);
#pragma unroll
            for (int j = 0; j < 8; ++j) ov[j] = (y[j] * rstd * lnw[col + j] + lnb[col + j] + bon * vv[j]) * g[j];
            *(GAS v4u*)(ARWKV + m * DC + col) = pack8(ov);
        }
        lds_barrier();
    }
#undef S3_LOAD
}

constexpr int NPH = 13;
constexpr int NSTEPS = 1 + NL * NPH + 1;
__global__ void __launch_bounds__(NWAVES * 64, 2) trunk_fwd(Args args) {
    extern __shared__ __attribute__((aligned(16))) unsigned char lds[];
    Frame F;
    F.lds = (LAS unsigned char*)lds;
    F.wave = __builtin_amdgcn_readfirstlane((int)threadIdx.x >> 6);
    F.G = gridDim.x; { const int bx = blockIdx.x; F.vcu = (F.G % 8 == 0) ? (bx % 8) * (F.G / 8) + bx / 8 : bx; }
    F.out = args.out; F.ws = args.ws;
    volatile LAS unsigned* MISC = (volatile LAS unsigned*)(F.lds + MISC_OFF);
    for (int u = threadIdx.x; u < (LDS_BYTES - LDSCTL_OFF) / 4; u += NWAVES * 64) ((LAS unsigned*)(F.lds + LDSCTL_OFF))[u] = 0u;
    __syncthreads();
    const int lo = args.st_lo, hi = args.st_hi;
    const bool use_bar = (hi - lo) > 1;
    unsigned* barw = (unsigned*)(F.ws + WS_CTL) + CW_BAR;
    XcdBarrier bar; bar.bar = barw; bar.x = 0; bar.st = nullptr; bar.wave = F.wave;
    if (use_bar) bar = xcd_barrier_post(barw, MISC + 8, F.wave);
#define IN(k) (lo <= (k) && (k) < hi)
#define SEAM(k) do { if (IN(k) && IN((k) + 1)) xcd_barrier(bar); } while (0)
    PG8_LAS unsigned char* ring = F.lds + RING_OFF;
    const int bx = (int)blockIdx.x;

    if (IN(0)) { phase_prologue(F); } SEAM(0);
#define WSL const int l = launder_si(lq); unsigned char* ws = launder_s(F.ws); bf16* HB = (bf16*)(ws + WS_HB); bf16* PU = (bf16*)(ws + WS_PU); bf16* Z = (bf16*)(ws + WS_RKV); (void)HB; (void)PU; (void)Z
    for (int lq = 0; lq < NL; ++lq) {
        const int s0 = 1 + lq * NPH;
        if (IN(s0 + 0)) phase_norm(F, launder_si(lq), 0);
        SEAM(s0 + 0);
        if (IN(s0 + 1)) { WSL; pg8::Gemm g{HB, (const bf16*)(ws + WS_WIN + l * SZ_WIN), MA, DIN, D}; pg8::Order S; S.init(M / 256, DIN / 256, F.G, bx, D, 13, OFF_R / 256);
            pg8::EpiBf16 E{(GAS bf16*)PU, DIN, 0}; pg8::gemm_phase<pg8::EpiBf16, pg8::Order, true, true>(ring, g, S, E, F.wave); }
        SEAM(s0 + 1);
        if (IN(s0 + 2)) phase_mix(F, launder_si(lq));
        SEAM(s0 + 2);
        if (IN(s0 + 3)) { WSL; const kptr_t ka = kargs(); pg8::Gemm g{(const bf16*)(ws + WS_LL), (const bf16*)(ws + WS_WLORA + l * SZ_WLORA), M, 3072, 256}; pg8::Order S; S.init(M / 256, 12, F.G, bx, 256);
            pg8::EpiLora E{(GAS float*)(ws + WS_WD), (GAS bf16*)(ws + WS_AA), (GAS bf16*)(ws + WS_GG), (const GAS float*)(INP(9) + (size_t)l * DC), (const GAS float*)(INP(11) + (size_t)l * DC)};
            pg8::gemm_phase<pg8::EpiLora, pg8::Order, true, true>(ring, g, S, E, F.wave); }
        SEAM(s0 + 3);
        if (IN(s0 + 4)) phase_scan1(F, launder_si(lq));
        SEAM(s0 + 4);
        if (IN(s0 + 5)) phase_scan2(F, launder_si(lq));
        SEAM(s0 + 5);
        if (IN(s0 + 6)) phase_scan3(F, launder_si(lq));
        SEAM(s0 + 6);
        if (IN(s0 + 7)) { WSL; pg8::Gemm g{(const bf16*)(ws + WS_ACONV), (const bf16*)(ws + WS_WOC + l * SZ_WOC), M, D, DC}; pg8::Order S; S.init(MP / 256, D / 256, F.G, bx, DC, (MS / 256) * (D / 256) * 4, 0, 4, 4, 0);
            pg8::EpiGate E{(GAS bf16*)Z, (const GAS bf16*)(PU + OFF_GC), DIN, 0, (GAS bf16*)(ws + WS_WD), MP}; pg8::gemm_phase<pg8::EpiGate, pg8::Order, true, true>(ring, g, S, E, F.wave); }
        if (IN(s0 + 7)) { WSL; pg8::Gemm g{(const bf16*)(ws + WS_ARWKV), (const bf16*)(ws + WS_WOR + l * SZ_WOC), M, D, DC}; pg8::Order S; S.init(MP / 256, D / 256, F.G, bx, DC, (MS / 256) * (D / 256) * 4, 0, 4, 4, F.G / 2);
            pg8::EpiGate E{(GAS bf16*)Z, (const GAS bf16*)(PU + OFF_GR), DIN, 1, (GAS bf16*)(ws + WS_AA), MP}; pg8::gemm_phase<pg8::EpiGate, pg8::Order, true, true>(ring, g, S, E, F.wave); }
        SEAM(s0 + 7);
        if (IN(s0 + 8)) phase_zred(F);
        SEAM(s0 + 8);
        if (IN(s0 + 9)) { WSL; pg8::Gemm g{Z, (const bf16*)(ws + WS_WO + l * SZ_WO), M, D, D}; pg8::Order S; S.init(MP / 256, D / 256, F.G, bx, D, (MS / 256) * (D / 256) * 8, 0, 8);
            GAS bf16* XB = (GAS bf16*)launder_s(F.out); pg8::EpiRes E{XB, XB, D, (GAS bf16*)(ws + WS_WD), MP}; pg8::gemm_phase<pg8::EpiRes, pg8::Order, true, true>(ring, g, S, E, F.wave); }
        SEAM(s0 + 9);
        if (IN(s0 + 10)) phase_norm(F, launder_si(lq), 1);
        SEAM(s0 + 10);
        if (IN(s0 + 11)) { WSL; pg8::Gemm g{HB, (const bf16*)(ws + WS_WUP + l * SZ_WUP), M, DFF, D}; pg8::Order S; S.init(M / 256, DFF / 256, F.G, bx, D);
            pg8::EpiBf16 E{(GAS bf16*)PU, DFF, 1}; pg8::gemm_phase<pg8::EpiBf16, pg8::Order, true, true>(ring, g, S, E, F.wave); }
        SEAM(s0 + 11);
        if (IN(s0 + 12)) { WSL; pg8::Gemm g{PU, (const bf16*)(ws + WS_WDN + l * SZ_WUP), M, D, DFF}; pg8::Order S; S.init(MP / 256, D / 256, F.G, bx, DFF, (MS / 256) * (D / 256) * 8, 0, 8);
            GAS bf16* XB = (GAS bf16*)launder_s(F.out); GAS bf16* XO = (l == NL - 1) ? (GAS bf16*)(ws + WS_RKV) : XB;
            pg8::EpiRes E{XB, XO, D, (GAS bf16*)(ws + WS_WD), MP}; pg8::gemm_phase<pg8::EpiRes, pg8::Order, true, true>(ring, g, S, E, F.wave); }
        SEAM(s0 + 12);
    }
    if (IN(NSTEPS - 1)) phase_norm(F, 0, 2);
#undef IN
#undef SEAM
}

extern "C" void kernel_launch(void* const* d_in, const int* in_sizes, int n_in, void* d_out, int out_size, void* d_ws, size_t ws_size, hipStream_t stream) {
    static int grid = 0;
    if (grid == 0) {
        if (n_in != 26 || (size_t)out_size != O_END || ws_size < WS_END) { fprintf(stderr, "kernel_launch: shape mismatch n_in %d out %d ws %zu (need %zu)\n", n_in, out_size, ws_size, (size_t)WS_END); grid = -1; return; }
        int dev = 0, cus = 0, per_cu = 0;
        if (hipGetDevice(&dev) != hipSuccess || hipDeviceGetAttribute(&cus, hipDeviceAttributeMultiprocessorCount, dev) != hipSuccess) { grid = -1; return; }
        if (hipFuncSetAttribute((const void*)trunk_fwd, hipFuncAttributeMaxDynamicSharedMemorySize, LDS_BYTES) != hipSuccess) { fprintf(stderr, "kernel_launch: hipFuncSetAttribute failed\n"); grid = -1; return; }
        if (hipOccupancyMaxActiveBlocksPerMultiprocessor(&per_cu, (const void*)trunk_fwd, NWAVES * 64, LDS_BYTES) != hipSuccess || per_cu < 1)
            fprintf(stderr, "kernel_launch: occupancy query reports %d workgroups per CU\n", per_cu);
        (void)hipGetLastError();
        grid = cus;
    }
    if (grid < 0) return;
    if (hipMemsetAsync((char*)d_ws + WS_CTL, 0, CTL_ZERO_BYTES, stream) != hipSuccess) return;
    Args a{};
    for (int i = 0; i < 26; ++i) a.in[i] = (const float*)d_in[i];
    a.out = (float*)d_out; a.ws = (unsigned char*)d_ws;
#if MK_ONE_LAUNCH
    a.st_lo = 0; a.st_hi = NSTEPS;
    hipLaunchKernelGGL(trunk_fwd, dim3(grid), dim3(NWAVES * 64), LDS_BYTES, stream, a);
#else
    for (int s = 0; s < NSTEPS; ++s) {
        a.st_lo = s; a.st_hi = s + 1;
        hipLaunchKernelGGL(trunk_fwd, dim3(grid), dim3(NWAVES * 64), LDS_BYTES, stream, a);
    }
#endif
}
```

```cpp
#include <hip/hip_runtime.h>
#include <cstdio>
#include <cstdint>

#ifndef MK_ONE_LAUNCH
#define MK_ONE_LAUNCH 1
#endif

__device__ __forceinline__ int lane_id_asm() { int v; asm volatile("v_mbcnt_lo_u32_b32 %0, -1, 0\n\tv_mbcnt_hi_u32_b32 %0, -1, %0" : "=v"(v)); return v; }

namespace pg8 {
#define PG8_LAS __attribute__((address_space(3)))
#define PG8_GAS __attribute__((address_space(1)))
typedef unsigned short bf16_t;
typedef short bf16x8 __attribute__((ext_vector_type(8)));
typedef float f32x4 __attribute__((ext_vector_type(4)));
typedef unsigned u32x4 __attribute__((ext_vector_type(4)));
typedef unsigned u32x2 __attribute__((ext_vector_type(2)));
constexpr int BM = 256, BK = 64, HALF = 128, HTB = HALF * BK * 2, STAGE_BYTES = 8 * HTB, NXCD = 8;

__host__ __device__ __forceinline__ int lds_byte(int r, int c) { const int st = (r >> 4) * 2 + (c >> 5), rr = r & 15, cc = c & 31, ob = rr * 64 + cc * 2; return st * 1024 + (ob ^ (((ob >> 9) & 1) << 5)); }
__host__ __device__ __forceinline__ void stage_rc(int b, int& R, int& C) { const int st = b / 1024, sb = b % 1024, swz = sb ^ (((sb >> 9) & 1) << 5); R = (st >> 1) * 16 + swz / 64; C = (st & 1) * 32 + (swz % 64) / 2; }
__host__ __device__ __forceinline__ int perm32(int rho) { const int n = rho >> 4, i = rho & 15; return 8 * (i >> 2) + 4 * n + (i & 3); }

struct Unit { int pm, pn, kt0, nkt, ks; };
struct Gemm { const bf16_t* A; const bf16_t* Bt; int M, N, K; };

struct Order {
    int nM, nN, nwg, G, c, nX, x0, nktf, sk, WGM, xoff;
    __device__ void init(int nM_, int nN_, int G_, int c_, int K_, int nX_ = 0, int x0_ = 0, int sk_ = 0, int wgm_ = 4, int xoff_ = 0) { WGM = wgm_; xoff = xoff_; nM = nM_; nN = nN_; nwg = nM * nN; G = G_; c = c_; nX = nX_; x0 = x0_; nktf = K_ / BK; sk = sk_; }
    __device__ bool next(int i, Unit& u) const {
        const long L = (long)i * G + c; if (L >= nwg + nX + xoff) return false;
        u.kt0 = 0; u.nkt = nktf; u.ks = -1;
        if (L >= nwg) { const int j = (int)(L - nwg) - xoff; if (j < 0) return false;
            if (sk) { const int uu = j / sk; u.ks = j % sk; u.pm = nM + uu / nN; u.pn = uu % nN; u.nkt = nktf / sk; u.kt0 = u.ks * u.nkt; }
            else { u.pm = nM; u.pn = x0 + j; }
            return true; }
        int wgid = (int)L; { const int q = nwg / NXCD, r = nwg % NXCD, xcd = wgid % NXCD, off = wgid / NXCD; wgid = (xcd < r ? xcd * (q + 1) : r * (q + 1) + (xcd - r) * q) + off; }
        const int nig = WGM * nN, gid = wgid / nig, fm = gid * WGM, gsz = (nM - fm) < WGM ? (nM - fm) : WGM;
        u.pm = fm + ((wgid % nig) % gsz); u.pn = (wgid % nig) / gsz; return true;
    }
    __device__ __forceinline__ void a_ready(const Unit&) const {}
    __device__ __forceinline__ void done(const Unit&) const {}
};

typedef float f32x2c __attribute__((ext_vector_type(2)));
typedef __bf16 bf16x2c __attribute__((ext_vector_type(2)));
__device__ __forceinline__ unsigned cvt_pk_bf16(float lo, float hi) { const f32x2c f = {lo, hi}; return __builtin_bit_cast(unsigned, __builtin_convertvector(f, bf16x2c)); }
__device__ __forceinline__ float bf_lo(unsigned w) { return __builtin_bit_cast(float, w << 16); }
__device__ __forceinline__ float bf_hi(unsigned w) { return __builtin_bit_cast(float, w & 0xffff0000u); }
__device__ __forceinline__ float sigmoidf_(float x) { return __builtin_amdgcn_rcpf(1.0f + __expf(-x)); }

struct EpiBf16 {
    static constexpr bool PERM = true, AFTER_DRAIN = false;
    PG8_GAS bf16_t* O; int ldc; int act;
    __device__ __forceinline__ void operator()(const f32x4 (&acc)[2][2][4][2], const Unit& u, int wr, int wc, int fr, int fq) const {
        { const int l_ = lane_id_asm(); fr = l_ & 15; fq = l_ >> 4; }
        const int row0 = u.pm * BM + wr * 64 + fr, col0 = u.pn * BM + wc * 32 + 8 * fq;
#pragma unroll
        for (int ai = 0; ai < 2; ++ai)
#pragma unroll
            for (int m = 0; m < 4; ++m) { PG8_GAS bf16_t* rowp = O + (size_t)(row0 + ai * HALF + m * 16) * ldc + col0;
#pragma unroll
                for (int bj = 0; bj < 2; ++bj) { f32x4 v0 = acc[ai][bj][m][0], v1 = acc[ai][bj][m][1];
                    if (act) {
#pragma unroll
                        for (int j = 0; j < 4; ++j) { const float a = fmaxf(v0[j], 0.f), b = fmaxf(v1[j], 0.f); v0[j] = a * a; v1[j] = b * b; } }
                    u32x4 w; w.x = cvt_pk_bf16(v0[0], v0[1]); w.y = cvt_pk_bf16(v0[2], v0[3]); w.z = cvt_pk_bf16(v1[0], v1[1]); w.w = cvt_pk_bf16(v1[2], v1[3]);
                    *(PG8_GAS u32x4*)(rowp + bj * HALF) = w; } }
    }
};
struct EpiRes {
    static constexpr bool PERM = true, AFTER_DRAIN = false;
    const PG8_GAS bf16_t* Xin; PG8_GAS bf16_t* Xout; int ldc; PG8_GAS bf16_t* SL; int row0s;
    __device__ __forceinline__ void operator()(const f32x4 (&acc)[2][2][4][2], const Unit& u, int wr, int wc, int fr, int fq) const {
        { const int l_ = lane_id_asm(); fr = l_ & 15; fq = l_ >> 4; }
        const int row0 = u.pm * BM + wr * 64 + fr, col0 = u.pn * BM + wc * 32 + 8 * fq;
        if (u.ks >= 0) {
            PG8_GAS bf16_t* base = SL + ((size_t)u.ks * 1024 + (row0 - row0s)) * ldc + col0;
#pragma unroll
            for (int ai = 0; ai < 2; ++ai)
#pragma unroll
                for (int m = 0; m < 4; ++m)
#pragma unroll
                    for (int bj = 0; bj < 2; ++bj) { const f32x4 v0 = acc[ai][bj][m][0], v1 = acc[ai][bj][m][1];
                        u32x4 w; w.x = cvt_pk_bf16(v0[0], v0[1]); w.y = cvt_pk_bf16(v0[2], v0[3]); w.z = cvt_pk_bf16(v1[0], v1[1]); w.w = cvt_pk_bf16(v1[2], v1[3]);
                        *(PG8_GAS u32x4*)(base + (size_t)(ai * HALF + m * 16) * ldc + bj * HALF) = w; }
            return;
        }
#pragma unroll
        for (int ai = 0; ai < 2; ++ai) {
            u32x4 xv[4][2];
#pragma unroll
            for (int m = 0; m < 4; ++m)
#pragma unroll
                for (int bj = 0; bj < 2; ++bj) xv[m][bj] = *(const PG8_GAS u32x4*)(Xin + (size_t)(row0 + ai * HALF + m * 16) * ldc + col0 + bj * HALF);
#pragma unroll
            for (int m = 0; m < 4; ++m)
#pragma unroll
                for (int bj = 0; bj < 2; ++bj) { const u32x4 x = xv[m][bj]; const f32x4 v0 = acc[ai][bj][m][0], v1 = acc[ai][bj][m][1];
                    u32x4 w; w.x = cvt_pk_bf16(bf_lo(x.x) + v0[0], bf_hi(x.x) + v0[1]); w.y = cvt_pk_bf16(bf_lo(x.y) + v0[2], bf_hi(x.y) + v0[3]);
                    w.z = cvt_pk_bf16(bf_lo(x.z) + v1[0], bf_hi(x.z) + v1[1]); w.w = cvt_pk_bf16(bf_lo(x.w) + v1[2], bf_hi(x.w) + v1[3]);
                    *(PG8_GAS u32x4*)(Xout + (size_t)(row0 + ai * HALF + m * 16) * ldc + col0 + bj * HALF) = w; }
            asm volatile("" ::: "memory"); }
    }
};
struct EpiLora {
    static constexpr bool PERM = false, AFTER_DRAIN = false;
    PG8_GAS float* WD; PG8_GAS bf16_t* AA; PG8_GAS bf16_t* GG; const PG8_GAS float* w0; const PG8_GAS float* a0;
    __device__ __forceinline__ void operator()(const f32x4 (&acc)[2][2][4][2], const Unit& u, int wr, int wc, int fr, int fq) const {
        { const int l_ = lane_id_asm(); fr = l_ & 15; fq = l_ >> 4; }
        const int t = u.pn >> 2, row0 = u.pm * BM + wr * 64 + fr, col0 = (u.pn & 3) * BM + wc * 32 + 4 * fq;
        if (t == 2) {
#pragma unroll
            for (int ai = 0; ai < 2; ++ai)
#pragma unroll
                for (int m = 0; m < 4; ++m) { PG8_GAS bf16_t* rp = GG + (size_t)(row0 + ai * HALF + m * 16) * 1024 + col0;
#pragma unroll
                    for (int bj = 0; bj < 2; ++bj)
#pragma unroll
                        for (int n = 0; n < 2; ++n) { const f32x4 v = acc[ai][bj][m][n]; u32x2 w; w.x = cvt_pk_bf16(v[0], v[1]); w.y = cvt_pk_bf16(v[2], v[3]); *(PG8_GAS u32x2*)(rp + bj * HALF + n * 16) = w; } }
        } else if (t == 1) {
#pragma unroll
            for (int bj = 0; bj < 2; ++bj)
#pragma unroll
                for (int n = 0; n < 2; ++n) { const f32x4 bv = *(const PG8_GAS f32x4*)(a0 + col0 + bj * HALF + n * 16);
#pragma unroll
                    for (int ai = 0; ai < 2; ++ai)
#pragma unroll
                        for (int m = 0; m < 4; ++m) { f32x4 v = acc[ai][bj][m][n] + bv;
#pragma unroll
                            for (int j = 0; j < 4; ++j) v[j] = sigmoidf_(v[j]);
                            u32x2 w; w.x = cvt_pk_bf16(v[0], v[1]); w.y = cvt_pk_bf16(v[2], v[3]);
                            *(PG8_GAS u32x2*)(AA + (size_t)(row0 + ai * HALF + m * 16) * 1024 + col0 + bj * HALF + n * 16) = w; } }
        } else {
#pragma unroll
            for (int bj = 0; bj < 2; ++bj)
#pragma unroll
                for (int n = 0; n < 2; ++n) { const f32x4 bv = *(const PG8_GAS f32x4*)(w0 + col0 + bj * HALF + n * 16);
#pragma unroll
                    for (int ai = 0; ai < 2; ++ai)
#pragma unroll
                        for (int m = 0; m < 4; ++m) { f32x4 v = acc[ai][bj][m][n] + bv;
#pragma unroll
                            for (int j = 0; j < 4; ++j) v[j] = -0.60653065971263342f * sigmoidf_(v[j]);
                            *(PG8_GAS f32x4*)(WD + (size_t)(row0 + ai * HALF + m * 16) * 1024 + col0 + bj * HALF + n * 16) = v; } }
        }
    }
};
struct EpiGate {
    static constexpr bool PERM = true, AFTER_DRAIN = false;
    PG8_GAS bf16_t* Z; const PG8_GAS bf16_t* Pg; int ldp; int add; PG8_GAS bf16_t* SL; int row0s;
    __device__ __forceinline__ void operator()(const f32x4 (&acc)[2][2][4][2], const Unit& u, int wr, int wc, int fr, int fq) const {
        { const int l_ = lane_id_asm(); fr = l_ & 15; fq = l_ >> 4; }
        const int row0 = u.pm * BM + wr * 64 + fr, col0 = u.pn * BM + wc * 32 + 8 * fq;
        if (u.ks >= 0) {
            PG8_GAS bf16_t* base = SL + ((size_t)u.ks * 1024 + (row0 - row0s)) * 2048 + col0;
#pragma unroll
            for (int ai = 0; ai < 2; ++ai)
#pragma unroll
                for (int m = 0; m < 4; ++m)
#pragma unroll
                    for (int bj = 0; bj < 2; ++bj) { const f32x4 v0 = acc[ai][bj][m][0], v1 = acc[ai][bj][m][1];
                        u32x4 w; w.x = cvt_pk_bf16(v0[0], v0[1]); w.y = cvt_pk_bf16(v0[2], v0[3]); w.z = cvt_pk_bf16(v1[0], v1[1]); w.w = cvt_pk_bf16(v1[2], v1[3]);
                        *(PG8_GAS u32x4*)(base + (size_t)(ai * HALF + m * 16) * 2048 + bj * HALF) = w; }
            return;
        }
#pragma unroll
        for (int ai = 0; ai < 2; ++ai) {
            u32x4 gw[4][2], zo[4][2];
#pragma unroll
            for (int m = 0; m < 4; ++m) { const int row = row0 + ai * HALF + m * 16;
#pragma unroll
                for (int bj = 0; bj < 2; ++bj) { gw[m][bj] = *(const PG8_GAS u32x4*)(Pg + (size_t)row * ldp + col0 + bj * HALF);
                    zo[m][bj] = add ? *(const PG8_GAS u32x4*)(Z + (size_t)row * 2048 + col0 + bj * HALF) : (u32x4){0u, 0u, 0u, 0u}; } }
#pragma unroll
            for (int m = 0; m < 4; ++m) { const int row = row0 + ai * HALF + m * 16;
#pragma unroll
                for (int bj = 0; bj < 2; ++bj) { const u32x4 g = gw[m][bj], z = zo[m][bj];
                    f32x4 v0 = acc[ai][bj][m][0], v1 = acc[ai][bj][m][1];
                    v0[0] = v0[0] * sigmoidf_(bf_lo(g.x)) + bf_lo(z.x); v0[1] = v0[1] * sigmoidf_(bf_hi(g.x)) + bf_hi(z.x); v0[2] = v0[2] * sigmoidf_(bf_lo(g.y)) + bf_lo(z.y); v0[3] = v0[3] * sigmoidf_(bf_hi(g.y)) + bf_hi(z.y);
                    v1[0] = v1[0] * sigmoidf_(bf_lo(g.z)) + bf_lo(z.z); v1[1] = v1[1] * sigmoidf_(bf_hi(g.z)) + bf_hi(z.z); v1[2] = v1[2] * sigmoidf_(bf_lo(g.w)) + bf_lo(z.w); v1[3] = v1[3] * sigmoidf_(bf_hi(g.w)) + bf_hi(z.w);
                    u32x4 w; w.x = cvt_pk_bf16(v0[0], v0[1]); w.y = cvt_pk_bf16(v0[2], v0[3]); w.z = cvt_pk_bf16(v1[0], v1[1]); w.w = cvt_pk_bf16(v1[2], v1[3]);
                    *(PG8_GAS u32x4*)(Z + (size_t)row * 2048 + col0 + bj * HALF) = w; } }
            asm volatile("" ::: "memory"); }
    }
};

template <class Epi, class Sched, bool ALIGN_EPI = false, bool SP2 = false>
__device__ __forceinline__ void gemm_phase(PG8_LAS unsigned char* lds, const Gemm g, const Sched& S, const Epi& E, int wid_in) {
    const int lane_ = lane_id_asm();
    const int wid = __builtin_amdgcn_readfirstlane(wid_in), lane = lane_, tid = wid * 64 + lane, wr = wid >> 2, wc = wid & 3, fr = lane & 15, fq = lane >> 4;
    const int K = g.K;
    unsigned voffA[2], voffB[2];
#pragma unroll
    for (int i = 0; i < 2; ++i) { int R, C; stage_rc(tid * 16 + i * 8192, R, C); const int Rb = Epi::PERM ? ((R & ~31) + perm32(R & 31)) : R;
        voffA[i] = (unsigned)(R * K + C) * 2u; voffB[i] = (unsigned)(Rb * K + C) * 2u; }
    const size_t kstep = (size_t)(BK * 2);
    const size_t hstep = (size_t)HALF * K * 2;
    const size_t tstep = 2 * hstep;
    const unsigned ldsw = (unsigned)wid * 1024u;
    const int aoff = lds_byte(wr * 64 + fr, fq * 8), boff = lds_byte(wc * 32 + fr, fq * 8);
#define PG8_SA(b, h) (((b) * 2 + (h)) * HTB)
#define PG8_SB(b, h) ((4 + (b) * 2 + (h)) * HTB)
#define PG8_STAGE(bufoff, gbase, voff) do { _Pragma("unroll") for (int _i = 0; _i < 2; ++_i) \
        __builtin_amdgcn_global_load_lds((const unsigned*)((const char*)(gbase) + (voff)[_i]), (PG8_LAS unsigned*)(lds + (bufoff) + ldsw + _i * 8192), 16, 0, 0); } while (0)
#define PG8_LDA(dst, b, h) do { _Pragma("unroll") for (int m = 0; m < 4; ++m) _Pragma("unroll") for (int k = 0; k < 2; ++k) dst[m][k] = *(const PG8_LAS bf16x8*)(lds + PG8_SA(b, h) + aoff + m * 2048 + k * 1024); } while (0)
#define PG8_LDB(dst, b, h) do { _Pragma("unroll") for (int n = 0; n < 2; ++n) _Pragma("unroll") for (int k = 0; k < 2; ++k) dst[n][k] = *(const PG8_LAS bf16x8*)(lds + PG8_SB(b, h) + boff + n * 2048 + k * 1024); } while (0)
#define PG8_MMA(ai, bj, At, Bt) do { __builtin_amdgcn_s_setprio(1); _Pragma("unroll") for (int m = 0; m < 4; ++m) _Pragma("unroll") for (int n = 0; n < 2; ++n) _Pragma("unroll") for (int k = 0; k < 2; ++k) \
        acc[ai][bj][m][n] = __builtin_amdgcn_mfma_f32_16x16x32_bf16(Bt[n][k], At[m][k], acc[ai][bj][m][n], 0, 0, 0); __builtin_amdgcn_s_setprio(0); } while (0)
#define PG8_WAIT_V(n) asm volatile("s_waitcnt vmcnt(" #n ")" ::: "memory")
#define PG8_WAIT_L(n) asm volatile("s_waitcnt lgkmcnt(" #n ")" ::: "memory")
#define PG8_BAR __builtin_amdgcn_s_barrier()
#define PG8_SCHED __builtin_amdgcn_sched_barrier(0)
    Unit cur, nxt; int ui = 0;
    if (!S.next(0, cur)) return;
    f32x4 acc[2][2][4][2];
#pragma unroll
    for (int a = 0; a < 2; ++a)
#pragma unroll
        for (int b = 0; b < 2; ++b)
#pragma unroll
            for (int m = 0; m < 4; ++m)
#pragma unroll
                for (int n = 0; n < 2; ++n) acc[a][b][m][n] = (f32x4){0.f, 0.f, 0.f, 0.f};
    bf16x8 At[4][2], B0[2][2], B1[2][2];
    const char* cA = (const char*)g.A + (size_t)cur.pm * tstep + (size_t)cur.kt0 * kstep; const char* cB = (const char*)g.Bt + (size_t)cur.pn * tstep + (size_t)cur.kt0 * kstep;
    S.a_ready(cur);
    if constexpr (SP2) {
        PG8_STAGE(PG8_SB(0, 0), cB, voffB); PG8_STAGE(PG8_SB(0, 1), cB + hstep, voffB); PG8_STAGE(PG8_SA(0, 0), cA, voffA); PG8_STAGE(PG8_SA(0, 1), cA + hstep, voffA);
        if (wr == 1) PG8_BAR;
        PG8_WAIT_V(2); PG8_BAR;
        PG8_STAGE(PG8_SB(1, 0), cB + kstep, voffB); PG8_STAGE(PG8_SA(1, 0), cA + kstep, voffA); PG8_STAGE(PG8_SB(1, 1), cB + hstep + kstep, voffB);
        PG8_WAIT_V(6); PG8_BAR;
    } else {
        PG8_STAGE(PG8_SB(0, 0), cB, voffB); PG8_STAGE(PG8_SA(0, 0), cA, voffA); PG8_STAGE(PG8_SB(0, 1), cB + hstep, voffB); PG8_STAGE(PG8_SA(0, 1), cA + hstep, voffA);
        if (wr == 1) PG8_BAR;
        PG8_WAIT_V(4); PG8_BAR;
        PG8_STAGE(PG8_SB(1, 0), cB + kstep, voffB); PG8_STAGE(PG8_SA(1, 0), cA + kstep, voffA); PG8_STAGE(PG8_SB(1, 1), cB + hstep + kstep, voffB);
        PG8_WAIT_V(6); PG8_BAR;
    }
    for (;;) {
        const bool has_next = S.next(ui + 1, nxt);
        const char* nA = has_next ? (const char*)g.A + (size_t)nxt.pm * tstep + (size_t)nxt.kt0 * kstep : cA; const char* nB = has_next ? (const char*)g.Bt + (size_t)nxt.pn * tstep + (size_t)nxt.kt0 * kstep : cB;
        const int nt = cur.nkt;
        for (int t = 0; t < nt; t += 2) {
            const bool last = (t == nt - 2);
            const char* a1 = cA + (size_t)(t + 1) * kstep;
            const char* a2 = last ? nA : cA + (size_t)(t + 2) * kstep; const char* b2 = last ? nB : cB + (size_t)(t + 2) * kstep;
            const char* a3 = a2 + kstep; const char* b3 = b2 + kstep;
            if (last && has_next) S.a_ready(nxt);
            if constexpr (SP2) {
            PG8_LDB(B0, 0, 0); PG8_LDB(B1, 0, 1); PG8_SCHED; PG8_LDA(At, 0, 0); PG8_STAGE(PG8_SA(1, 1), a1 + hstep, voffA);
            PG8_WAIT_V(8); PG8_WAIT_L(0); PG8_BAR; PG8_MMA(0, 0, At, B0); PG8_MMA(0, 1, At, B1); PG8_BAR; PG8_SCHED;
            PG8_LDA(At, 0, 1); PG8_STAGE(PG8_SB(0, 0), b2, voffB); PG8_STAGE(PG8_SB(0, 1), b2 + hstep, voffB); PG8_STAGE(PG8_SA(0, 0), a2, voffA);
            PG8_WAIT_V(8); PG8_WAIT_L(0); PG8_BAR; PG8_MMA(1, 0, At, B0); PG8_MMA(1, 1, At, B1); PG8_BAR; PG8_SCHED;
            PG8_LDB(B0, 1, 0); PG8_LDB(B1, 1, 1); PG8_SCHED; PG8_LDA(At, 1, 0); PG8_STAGE(PG8_SA(0, 1), a2 + hstep, voffA);
            PG8_WAIT_V(8); PG8_WAIT_L(0); PG8_BAR; PG8_MMA(0, 0, At, B0); PG8_MMA(0, 1, At, B1); PG8_BAR; PG8_SCHED;
            PG8_LDA(At, 1, 1); PG8_STAGE(PG8_SB(1, 0), b3, voffB); PG8_STAGE(PG8_SB(1, 1), b3 + hstep, voffB); PG8_STAGE(PG8_SA(1, 0), a3, voffA);
            PG8_WAIT_V(8); PG8_WAIT_L(0); PG8_BAR; PG8_MMA(1, 0, At, B0); PG8_MMA(1, 1, At, B1); PG8_BAR; PG8_SCHED;
            } else {
            PG8_LDB(B0, 0, 0); PG8_SCHED; PG8_LDA(At, 0, 0); PG8_STAGE(PG8_SA(1, 1), a1 + hstep, voffA);
            PG8_WAIT_L(8); PG8_BAR; PG8_WAIT_L(0); PG8_MMA(0, 0, At, B0); PG8_BAR; PG8_SCHED;
            PG8_LDB(B1, 0, 1); PG8_STAGE(PG8_SB(0, 0), b2, voffB);
            PG8_BAR; PG8_WAIT_L(0); PG8_MMA(0, 1, At, B1); PG8_BAR;
            PG8_LDA(At, 0, 1); PG8_STAGE(PG8_SA(0, 0), a2, voffA);
            PG8_BAR; PG8_WAIT_L(0); PG8_MMA(1, 0, At, B0); PG8_BAR; PG8_SCHED;
            PG8_STAGE(PG8_SB(0, 1), b2 + hstep, voffB);
            PG8_WAIT_V(6); PG8_BAR; PG8_MMA(1, 1, At, B1); PG8_BAR;
            PG8_LDB(B0, 1, 0); PG8_SCHED; PG8_LDA(At, 1, 0); PG8_STAGE(PG8_SA(0, 1), a2 + hstep, voffA);
            PG8_WAIT_L(8); PG8_BAR; PG8_WAIT_L(0); PG8_MMA(0, 0, At, B0); PG8_BAR; PG8_SCHED;
            PG8_LDB(B1, 1, 1); PG8_STAGE(PG8_SB(1, 0), b3, voffB);
            PG8_BAR; PG8_WAIT_L(0); PG8_MMA(0, 1, At, B1); PG8_BAR;
            PG8_LDA(At, 1, 1); PG8_STAGE(PG8_SA(1, 0), a3, voffA);
            PG8_BAR; PG8_WAIT_L(0); PG8_MMA(1, 0, At, B0); PG8_BAR; PG8_SCHED;
            PG8_STAGE(PG8_SB(1, 1), b3 + hstep, voffB);
            PG8_WAIT_V(6); PG8_BAR; PG8_MMA(1, 1, At, B1); PG8_BAR;
            }
        }
        if constexpr (ALIGN_EPI) { if (wr == 0) PG8_BAR; }
        E(acc, cur, wr, wc, fr, fq); S.done(cur);
        if (!has_next) break;
#pragma unroll
        for (int a = 0; a < 2; ++a)
#pragma unroll
            for (int b = 0; b < 2; ++b)
#pragma unroll
                for (int m = 0; m < 4; ++m)
#pragma unroll
                    for (int n = 0; n < 2; ++n) acc[a][b][m][n] = (f32x4){0.f, 0.f, 0.f, 0.f};
        cur = nxt; cA = nA; cB = nB; ++ui;
        if constexpr (ALIGN_EPI) { if (wr == 1) PG8_BAR; }
    }
    PG8_WAIT_V(0);
    if constexpr (!ALIGN_EPI) { if (wr == 0) PG8_BAR; }
    PG8_BAR;
#undef PG8_SA
#undef PG8_SB
#undef PG8_STAGE
#undef PG8_LDA
#undef PG8_LDB
#undef PG8_MMA
#undef PG8_WAIT_V
#undef PG8_WAIT_L
#undef PG8_BAR
#undef PG8_SCHED
}
}

constexpr int NWAVES = 8;
constexpr int D = 2048, DC = 1024, NH = 16, HD = 64, DIN = 10496, DFF = 8192, NL = 4;
constexpr int TP = 4096, TS = 64, BP = 4, BS = 16;
constexpr int MP = BP * TP, MS = BS * TS, M = MP + MS, MA = M + 256;
constexpr int OFF_CB = 1024, OFF_CC = 2048, OFF_R = 3072, OFF_GC = 6400, OFF_GR = 8448, DSHIFT = 3328;
constexpr float RMS_EPS = 1e-6f, GN_EPS = 64e-5f;
constexpr size_t O_YP = 0, O_YS = (size_t)MP * D, O_CONVP = O_YS + (size_t)MS * D, O_SHIFTP = O_CONVP + (size_t)NL * BP * 2 * DC, O_WKVP = O_SHIFTP + (size_t)NL * BP * D,
                 O_CONVS = O_WKVP + (size_t)NL * BP * NH * HD * HD, O_SHIFTS = O_CONVS + (size_t)NL * BS * 2 * DC, O_WKVS = O_SHIFTS + (size_t)NL * BS * D, O_END = O_WKVS + (size_t)NL * BS * NH * HD * HD;
constexpr size_t MiB = 1u << 20;
constexpr size_t WS_CTL = 0, CTL_ZERO_BYTES = 1 * MiB;
constexpr size_t SZ_WIN = (size_t)DIN * D * 2, SZ_WOC = (size_t)D * DC * 2, SZ_WO = (size_t)D * D * 2, SZ_WUP = (size_t)DFF * D * 2, SZ_WLORA = (size_t)3072 * 256 * 2;
constexpr size_t WS_WIN = 1 * MiB, WS_WOC = WS_WIN + NL * SZ_WIN, WS_WOR = WS_WOC + NL * SZ_WOC, WS_WO = WS_WOR + NL * SZ_WOC, WS_WUP = WS_WO + NL * SZ_WO, WS_WDN = WS_WUP + NL * SZ_WUP,
                 WS_WLORA = WS_WDN + NL * SZ_WUP;
constexpr size_t WS_HB = WS_WLORA + NL * SZ_WLORA;
constexpr size_t WS_PU = WS_HB + (size_t)MA * D * 2;
constexpr size_t WS_ACONV = WS_PU + (size_t)MA * DIN * 2;
constexpr size_t WS_ARWKV = WS_ACONV + (size_t)M * DC * 2;
constexpr size_t WS_RKV = WS_ARWKV + (size_t)M * DC * 2;
constexpr size_t WS_WD = WS_RKV + (size_t)M * 3072 * 2;
constexpr size_t WS_AA = WS_WD + (size_t)M * DC * 4;
constexpr size_t WS_GG = WS_AA + (size_t)M * DC * 4;
constexpr size_t WS_LL = WS_GG + (size_t)M * DC * 2;
constexpr size_t WS_END = WS_LL + (size_t)M * 256 * 2;
static_assert(WS_END <= 1375731712ull, "workspace map exceeds 4 x largest tensor");
static_assert((size_t)M * DFF * 2 <= (size_t)MA * DIN * 2 && (size_t)M * D * 2 <= (size_t)M * 3072 * 2, "overlays");
constexpr int CW_BAR = 4096;

constexpr int RING_OFF = 0, RING_BYTES = 131072;
constexpr int LDSCTL_OFF = RING_BYTES, MISC_OFF = LDSCTL_OFF + 320;
constexpr int LDS_BYTES = 147456;

#define GAS __attribute__((address_space(1)))
#define LAS __attribute__((address_space(3)))
typedef unsigned short bf16;
typedef unsigned v4u __attribute__((ext_vector_type(4)));
typedef unsigned v2u __attribute__((ext_vector_type(2)));
typedef float f32x4 __attribute__((ext_vector_type(4)));
typedef GAS unsigned gu32;
#define RLX_AGENT __ATOMIC_RELAXED, __HIP_MEMORY_SCOPE_AGENT
#define LDS_WAIT() asm volatile("s_waitcnt lgkmcnt(0)" ::: "memory")
#define VM_WAIT() asm volatile("s_waitcnt vmcnt(0)" ::: "memory")
__device__ __forceinline__ unsigned pk2(float lo, float hi) { return pg8::cvt_pk_bf16(lo, hi); }
__device__ __forceinline__ unsigned f2bf(float f) { return pk2(f, f) & 0xffffu; }
using pg8::bf_lo; using pg8::bf_hi; using pg8::sigmoidf_;

#define XB_TMO      128
#define XB_XCNT(j)  (256  + 64 * (j))
#define XB_XSUB(j)  (1280 + 64 * (j))
#define XB_XGEN(j)  (2304 + 64 * (j))
#define XB_TOP      3328
#define XB_TOPGEN   3392
#define XCD_BAR_WORDS 3456
#define XB_SPIN_CAP (1u << 18)
__device__ __forceinline__ unsigned xb_ld(unsigned* p)              { return __hip_atomic_load(p, __ATOMIC_RELAXED, __HIP_MEMORY_SCOPE_AGENT); }
__device__ __forceinline__ unsigned xb_add(unsigned* p, unsigned v) { return __hip_atomic_fetch_add(p, v, __ATOMIC_RELAXED, __HIP_MEMORY_SCOPE_AGENT); }
__device__ __forceinline__ unsigned xb_xcc_id() { return (unsigned)__builtin_amdgcn_s_getreg((3 << 11) | 20) & 0xFu; }
#define XB_SPIN(cond, bar) do { unsigned _sp = 0; while (cond) { __builtin_amdgcn_s_sleep(1); \
    if ((++_sp & 255u) == 0u) { if (xb_ld(&(bar)[XB_TMO])) break; if (_sp > XB_SPIN_CAP) { atomicAdd(&(bar)[XB_TMO], 1u); break; } } } } while (0)
struct XcdBarrier { unsigned* bar; unsigned x; volatile LAS unsigned* st; int wave; };
__device__ __forceinline__ bool xb_t0(int wave) { return wave == 0 && lane_id_asm() == 0; }
__device__ __forceinline__ XcdBarrier xcd_barrier_post(unsigned* bar, volatile LAS unsigned* st, int wave) {
    XcdBarrier b; b.bar = bar; b.x = xb_xcc_id(); b.st = st; b.wave = wave;
    if (xb_t0(wave)) (void)xb_add(&bar[XB_XCNT(b.x)], 1u);
    return b;
}
__device__ __forceinline__ void xcd_barrier_complete(unsigned* bar, unsigned x, unsigned& nloc, unsigned& nx) {
    const unsigned G = gridDim.x * gridDim.y * gridDim.z;
    unsigned sum, cnt, mine, sp = 0u;
    for (;;) {
        sum = 0u; cnt = 0u; mine = 0u;
#pragma unroll
        for (unsigned j = 0; j < 16; ++j) { const unsigned c = xb_ld(&bar[XB_XCNT(j)]); sum += c; cnt += (c > 0u) ? 1u : 0u; mine = (j == x) ? c : mine; }
        if (sum == G) break;
        __builtin_amdgcn_s_sleep(1);
        if ((++sp & 255u) == 0u) { if (xb_ld(&bar[XB_TMO])) break; if (sp > XB_SPIN_CAP) { atomicAdd(&bar[XB_TMO], 1u); break; } }
    }
    nloc = mine > 0u ? mine : 1u; nx = cnt > 0u ? cnt : 1u;
}
__device__ __forceinline__ void xcd_barrier(const XcdBarrier& b) {
    asm volatile("s_waitcnt vmcnt(0)" ::: "memory");
    __syncthreads();
    if (xb_t0(b.wave)) {
        unsigned* bar = b.bar; unsigned bx = b.x;
        asm volatile("" : "+s"(bar), "+s"(bx));
        __builtin_amdgcn_s_waitcnt(0);
        unsigned nloc = b.st[0], nx = b.st[1];
        if (nloc == 0u) { xcd_barrier_complete(bar, bx, nloc, nx); b.st[0] = nloc; b.st[1] = nx; }
        const unsigned old = xb_add(&bar[XB_XSUB(bx)], 1u);
        const unsigned gen = old / nloc;
        if (old + 1u == (gen + 1u) * nloc) {
            __builtin_amdgcn_fence(__ATOMIC_RELEASE, "agent");
            asm volatile("s_waitcnt vmcnt(0)" ::: "memory");
            const unsigned og = xb_add(&bar[XB_TOP], 1u);
            const unsigned tg = og / nx;
            if (og + 1u == (tg + 1u) * nx) xb_add(&bar[XB_TOPGEN], 1u);
            else XB_SPIN(xb_ld(&bar[XB_TOPGEN]) == tg, bar);
            __builtin_amdgcn_fence(__ATOMIC_ACQUIRE, "agent");
            xb_add(&bar[XB_XGEN(bx)], 1u);
            asm volatile("s_waitcnt vmcnt(0)" ::: "memory");
        } else {
            XB_SPIN(xb_ld(&bar[XB_XGEN(bx)]) == gen, bar);
            __builtin_amdgcn_fence(__ATOMIC_ACQUIRE, "agent");
            asm volatile("s_waitcnt vmcnt(0)" ::: "memory");
        }
    }
    __syncthreads();
}

struct Args { const float* in[26]; float* out; unsigned char* ws; int st_lo, st_hi; };
struct Frame {
    LAS unsigned char* lds;
    int wave, vcu, G;
    float* out; unsigned char* ws;
};
typedef const unsigned char __attribute__((address_space(4)))* kptr_t;
__device__ __forceinline__ kptr_t kargs() { kptr_t p = (kptr_t)__builtin_amdgcn_kernarg_segment_ptr(); asm volatile("" : "+s"(p)); return p; }
#define INP(k) (*(const float* const __attribute__((address_space(4)))*)(ka + 8 * (k)))
template <class T> __device__ __forceinline__ T* launder_s(T* p) { asm volatile("" : "+s"(p)); return p; }
template <class T> __device__ __forceinline__ LAS T* launder_l(LAS T* p) { asm volatile("" : "+v"(p)); return p; }
__device__ __forceinline__ int launder_si(int v) { asm volatile("" : "+s"(v)); return v; }
__device__ __forceinline__ int launder_v(int v) { asm volatile("" : "+v"(v)); return v; }
__device__ __forceinline__ void lds_barrier() { asm volatile("s_waitcnt lgkmcnt(0)" ::: "memory"); __builtin_amdgcn_s_barrier(); asm volatile("" ::: "memory"); }
template <int CTRL> __device__ __forceinline__ float dppf(float v) { return __builtin_bit_cast(float, __builtin_amdgcn_mov_dpp(__builtin_bit_cast(int, v), CTRL, 0xf, 0xf, true)); }
__device__ __forceinline__ float wave_sum(float v) {
    v += dppf<0xB1>(v); v += dppf<0x4E>(v); v += dppf<0x141>(v); v += dppf<0x140>(v);
    return (__builtin_bit_cast(float, __builtin_amdgcn_readlane(__builtin_bit_cast(int, v), 0)) + __builtin_bit_cast(float, __builtin_amdgcn_readlane(__builtin_bit_cast(int, v), 16))) +
           (__builtin_bit_cast(float, __builtin_amdgcn_readlane(__builtin_bit_cast(int, v), 32)) + __builtin_bit_cast(float, __builtin_amdgcn_readlane(__builtin_bit_cast(int, v), 48)));
}
__device__ __forceinline__ float sum8(float v) { v += dppf<0xB1>(v); v += dppf<0x4E>(v); v += dppf<0x141>(v); return v; }

__device__ __forceinline__ void p0_transpose_item(const float* W, int K, int N, bf16* WT, LAS float* scr, int item, int lane) {
    const int nblk = N / 32, kb = item / nblk, nb = item % nblk, k0 = 64 * kb, n0 = 32 * nb;
#pragma unroll 8
    for (int i = 0; i < 32; ++i) { const int kk = 2 * i + (lane >> 5); scr[kk * 33 + (lane & 31)] = ((const GAS float*)W)[(size_t)(k0 + kk) * N + n0 + (lane & 31)]; }
    LDS_WAIT(); asm volatile("" ::: "memory");
    const int c = lane & 7;
#pragma unroll
    for (int j = 0; j < 4; ++j) { const int n = (lane >> 3) + 8 * j; const LAS float* s = scr + (8 * c) * 33 + n;
        v4u o; o.x = pk2(s[0 * 33], s[1 * 33]); o.y = pk2(s[2 * 33], s[3 * 33]); o.z = pk2(s[4 * 33], s[5 * 33]); o.w = pk2(s[6 * 33], s[7 * 33]);
        *(GAS v4u*)(WT + (size_t)(n0 + n) * K + k0 + 8 * c) = o; }
    LDS_WAIT(); asm volatile("" ::: "memory");
}

__device__ __forceinline__ void phase_prologue(Frame& F) {
    const kptr_t ka = kargs(); const int lane = lane_id_asm(), tid = F.wave * 64 + lane; (void)tid; (void)ka;
    unsigned char* const ws_ = launder_s(F.ws); float* const out_ = launder_s(F.out); (void)ws_; (void)out_;
    LAS float* scr = (LAS float*)(F.lds + RING_OFF + F.wave * 16384);
    const int gw = launder_si(F.vcu * NWAVES + F.wave), NGW = F.G * NWAVES;
    constexpr int I_IN = (D / 64) * (DIN / 32), I_OC = (DC / 64) * (D / 32), I_O = (D / 64) * (D / 32), I_UP = (D / 64) * (DFF / 32), I_DN = (DFF / 64) * (D / 32);
    constexpr int PER_L = I_IN + 2 * I_OC + I_O + I_UP + I_DN, NITEMS = NL * PER_L;
    for (int it = gw; it < NITEMS; it += NGW) {
        const int l = it / PER_L; int r = it % PER_L;
        if (r < I_IN) { p0_transpose_item(INP(6) + (size_t)l * D * DIN, D, DIN, (bf16*)(ws_ + WS_WIN + l * SZ_WIN), scr, r, lane); continue; } r -= I_IN;
        if (r < I_OC) { p0_transpose_item(INP(19) + (size_t)l * DC * D, DC, D, (bf16*)(ws_ + WS_WOC + l * SZ_WOC), scr, r, lane); continue; } r -= I_OC;
        if (r < I_OC) { p0_transpose_item(INP(20) + (size_t)l * DC * D, DC, D, (bf16*)(ws_ + WS_WOR + l * SZ_WOC), scr, r, lane); continue; } r -= I_OC;
        if (r < I_O) { p0_transpose_item(INP(21) + (size_t)l * D * D, D, D, (bf16*)(ws_ + WS_WO + l * SZ_WO), scr, r, lane); continue; } r -= I_O;
        if (r < I_UP) { p0_transpose_item(INP(23) + (size_t)l * D * DFF, D, DFF, (bf16*)(ws_ + WS_WUP + l * SZ_WUP), scr, r, lane); continue; } r -= I_UP;
        p0_transpose_item(INP(24) + (size_t)l * DFF * D, DFF, D, (bf16*)(ws_ + WS_WDN + l * SZ_WUP), scr, r, lane);
    }
    const int gt = (F.vcu * NWAVES + F.wave) * 64 + lane, NGT = NGW * 64;
    for (int it = gt; it < NL * 3072 * 32; it += NGT) {
        const int l = it / (3072 * 32), rr = it % (3072 * 32), n = rr >> 5, k0 = (rr & 31) * 8;
        float v[8];
#pragma unroll
        for (int j = 0; j < 8; ++j) { const int k = k0 + j; float x = 0.f;
            if (n < 1024) { if (k < 64) x = ((const GAS float*)INP(10))[((size_t)l * 64 + k) * 1024 + n]; }
            else if (n < 2048) { if (k >= 64 && k < 128) x = ((const GAS float*)INP(12))[((size_t)l * 64 + (k - 64)) * 1024 + (n - 1024)]; }
            else { if (k >= 128) x = ((const GAS float*)INP(13))[((size_t)l * 128 + (k - 128)) * 1024 + (n - 2048)]; }
            v[j] = x; }
        v4u o; o.x = pk2(v[0], v[1]); o.y = pk2(v[2], v[3]); o.z = pk2(v[4], v[5]); o.w = pk2(v[6], v[7]);
        *(GAS v4u*)((bf16*)(ws_ + WS_WLORA + l * SZ_WLORA) + (size_t)n * 256 + k0) = o;
    }
}

__device__ __forceinline__ void unpack8(const v4u w, float (&f)[8]) { f[0] = bf_lo(w.x); f[1] = bf_hi(w.x); f[2] = bf_lo(w.y); f[3] = bf_hi(w.y); f[4] = bf_lo(w.z); f[5] = bf_hi(w.z); f[6] = bf_lo(w.w); f[7] = bf_hi(w.w); }
__device__ __forceinline__ v4u pack8(const float (&f)[8]) { v4u o; o.x = pk2(f[0], f[1]); o.y = pk2(f[2], f[3]); o.z = pk2(f[4], f[5]); o.w = pk2(f[6], f[7]); return o; }
__device__ __forceinline__ void phase_norm(Frame& F, int l, int mode) {
    const kptr_t ka = kargs(); const int lane = lane_id_asm(), tid = F.wave * 64 + lane; (void)tid; (void)ka;
    unsigned char* const ws_ = launder_s(F.ws); float* const out_ = launder_s(F.out); (void)ws_; (void)out_;
    const int gw = launder_si(F.vcu * NWAVES + F.wave), NGW = F.G * NWAVES;
    GAS bf16* XB = (GAS bf16*)out_; GAS bf16* XS = (GAS bf16*)(ws_ + WS_RKV); GAS bf16* HB = (GAS bf16*)(ws_ + WS_HB);
    const float* gain = (mode == 0) ? INP(5) + (size_t)l * D : (mode == 1) ? INP(22) + (size_t)l * D : INP(25);
    if (mode == 0 && gw < BS) {
        const int j = gw; GAS v2u* o8 = (GAS v2u*)(HB + (size_t)(M + j) * D) + lane;
#pragma unroll
        for (int q = 0; q < 8; ++q) { const f32x4 s = *((const GAS f32x4*)(INP(3) + ((size_t)l * BS + j) * D) + lane + 64 * q); v2u w; w.x = pk2(s.x, s.y); w.y = pk2(s.z, s.w); o8[64 * q] = w; }
    }
    f32x4 g[4][2];
#pragma unroll
    for (int q = 0; q < 4; ++q) { const GAS f32x4* gp = (const GAS f32x4*)(gain + q * 512 + lane * 8); g[q][0] = gp[0]; g[q][1] = gp[1]; }
    const bool from_in = (mode == 0 && l == 0);
    const GAS bf16* XR = (mode == 2) ? XS : XB;
    GAS bf16* XW = (mode == 1 && l == NL - 1) ? XS : XB;
    f32x4 nf[4][2]; v4u nb[4];
#define NORM_LOAD(mm) do { if (from_in) { const float* src_ = ((mm) < MP) ? INP(0) + (size_t)(mm) * D : INP(1) + (size_t)((mm) - MP) * D; \
            _Pragma("unroll") for (int q = 0; q < 4; ++q) { const GAS f32x4* p_ = (const GAS f32x4*)(src_ + q * 512 + lane * 8); nf[q][0] = p_[0]; nf[q][1] = p_[1]; } } \
        else { _Pragma("unroll") for (int q = 0; q < 4; ++q) nb[q] = *(const GAS v4u*)(XR + (size_t)(mm) * D + q * 512 + lane * 8); } } while (0)
    if (gw < M) NORM_LOAD(gw);
    for (int m = gw; m < M; m += NGW) {
        float v[4][8];
        if (from_in) {
#pragma unroll
            for (int q = 0; q < 4; ++q) { v[q][0] = nf[q][0].x; v[q][1] = nf[q][0].y; v[q][2] = nf[q][0].z; v[q][3] = nf[q][0].w; v[q][4] = nf[q][1].x; v[q][5] = nf[q][1].y; v[q][6] = nf[q][1].z; v[q][7] = nf[q][1].w; } }
        else {
#pragma unroll
            for (int q = 0; q < 4; ++q) unpack8(nb[q], v[q]); }
        if (m + NGW < M) NORM_LOAD(m + NGW);
        const bool slab = (m >= MP) && !from_in;
        if (slab) { const GAS bf16* SL = (const GAS bf16*)(ws_ + WS_WD) + (size_t)(m - MP) * D;
#pragma unroll
            for (int hq = 0; hq < 2; ++hq) {
                v4u sv[2][8];
#pragma unroll
                for (int q = 0; q < 2; ++q)
#pragma unroll
                    for (int k8 = 0; k8 < 8; ++k8) sv[q][k8] = *(const GAS v4u*)(SL + (size_t)k8 * MS * D + (2 * hq + q) * 512 + lane * 8);
#pragma unroll
                for (int q = 0; q < 2; ++q)
#pragma unroll
                    for (int k8 = 0; k8 < 8; ++k8) { float p[8]; unpack8(sv[q][k8], p);
#pragma unroll
                        for (int j = 0; j < 8; ++j) v[2 * hq + q][j] += p[j]; } } }
        if (from_in || (slab && mode != 2)) {
#pragma unroll
            for (int q = 0; q < 4; ++q) { const v4u w = pack8(v[q]); *(GAS v4u*)(XW + (size_t)m * D + q * 512 + lane * 8) = w; unpack8(w, v[q]); } }
        float s = 0.f;
#pragma unroll
        for (int q = 0; q < 4; ++q)
#pragma unroll
            for (int j = 0; j < 8; ++j) s += v[q][j] * v[q][j];
        const float rstd = __builtin_amdgcn_rsqf(wave_sum(s) * (1.f / D) + RMS_EPS);
#pragma unroll
        for (int q = 0; q < 4; ++q) { v[q][0] *= rstd * g[q][0].x; v[q][1] *= rstd * g[q][0].y; v[q][2] *= rstd * g[q][0].z; v[q][3] *= rstd * g[q][0].w; v[q][4] *= rstd * g[q][1].x; v[q][5] *= rstd * g[q][1].y; v[q][6] *= rstd * g[q][1].z; v[q][7] *= rstd * g[q][1].w; }
        if (mode == 2) {
#pragma unroll
            for (int q = 0; q < 4; ++q) { GAS f32x4* o = (GAS f32x4*)(out_ + (size_t)m * D + q * 512 + lane * 8); o[0] = (f32x4){v[q][0], v[q][1], v[q][2], v[q][3]}; o[1] = (f32x4){v[q][4], v[q][5], v[q][6], v[q][7]}; }
            continue; }
#pragma unroll
        for (int q = 0; q < 4; ++q) *(GAS v4u*)(HB + (size_t)m * D + q * 512 + lane * 8) = pack8(v[q]);
        if (mode == 0) {
            float* so = nullptr;
            if (m < MP) { if ((m & (TP - 1)) == TP - 1) so = out_ + O_SHIFTP + ((size_t)l * BP + (m >> 12)) * D; }
            else { const int ms = m - MP; if ((ms & (TS - 1)) == TS - 1) so = out_ + O_SHIFTS + ((size_t)l * BS + (ms >> 6)) * D; }
            if (so) {
#pragma unroll
                for (int q = 0; q < 4; ++q) { GAS f32x4* o = (GAS f32x4*)(so + q * 512 + lane * 8); o[0] = (f32x4){v[q][0], v[q][1], v[q][2], v[q][3]}; o[1] = (f32x4){v[q][4], v[q][5], v[q][6], v[q][7]}; } }
        }
    }
#undef NORM_LOAD
}

__device__ __forceinline__ void phase_mix(Frame& F, int l) {
    const kptr_t ka = kargs(); const int lane = lane_id_asm(), tid = F.wave * 64 + lane; (void)tid; (void)ka;
    unsigned char* const ws_ = launder_s(F.ws); float* const out_ = launder_s(F.out); (void)ws_; (void)out_;
    const int gw = launder_si(F.vcu * NWAVES + F.wave), NGW = F.G * NWAVES;
    const GAS bf16* P = (const GAS bf16*)(ws_ + WS_PU);
    GAS bf16* ACONV = (GAS bf16*)(ws_ + WS_ACONV); GAS bf16* RKV = (GAS bf16*)(ws_ + WS_RKV); GAS bf16* LL = (GAS bf16*)(ws_ + WS_LL);
    const GAS float* mu = (const GAS float*)(INP(7) + (size_t)l * DSHIFT); const GAS float* cw = (const GAS float*)(INP(8) + (size_t)l * 3 * DC);
    constexpr int NITEM = (M / 8) * 9;
    for (int it = gw; it < NITEM; it += NGW) {
        const int tb = it / 9, ch = it - tb * 9, m0 = tb * 8;
        int b, t0, T; bool samp;
        if (m0 < MP) { b = m0 >> 12; t0 = m0 & (TP - 1); T = TP; samp = false; } else { const int ms = m0 - MP; b = ms >> 6; t0 = ms & (TS - 1); T = TS; samp = true; }
        const GAS bf16* p0 = P + (size_t)m0 * DIN;
        if (ch < 2) {
            const int c = ch * 512 + lane * 8;
            v4u rin[10], rcc[10], rcb[8];
#pragma unroll
            for (int i = 0; i < 10; ++i) if (i >= 2 || t0 > 0) { rin[i] = *(const GAS v4u*)(p0 + (ptrdiff_t)(i - 2) * DIN + c); rcc[i] = *(const GAS v4u*)(p0 + (ptrdiff_t)(i - 2) * DIN + OFF_CC + c); }
#pragma unroll
            for (int i = 0; i < 8; ++i) rcb[i] = *(const GAS v4u*)(p0 + (size_t)i * DIN + OFF_CB + c);
            float w0[8], w1[8], w2[8];
            { const f32x4 a0 = *(const GAS f32x4*)(cw + c), a1 = *(const GAS f32x4*)(cw + c + 4), b0 = *(const GAS f32x4*)(cw + DC + c), b1 = *(const GAS f32x4*)(cw + DC + c + 4), c0 = *(const GAS f32x4*)(cw + 2 * DC + c), c1 = *(const GAS f32x4*)(cw + 2 * DC + c + 4);
              w0[0] = a0.x; w0[1] = a0.y; w0[2] = a0.z; w0[3] = a0.w; w0[4] = a1.x; w0[5] = a1.y; w0[6] = a1.z; w0[7] = a1.w;
              w1[0] = b0.x; w1[1] = b0.y; w1[2] = b0.z; w1[3] = b0.w; w1[4] = b1.x; w1[5] = b1.y; w1[6] = b1.z; w1[7] = b1.w;
              w2[0] = c0.x; w2[1] = c0.y; w2[2] = c0.z; w2[3] = c0.w; w2[4] = c1.x; w2[5] = c1.y; w2[6] = c1.z; w2[7] = c1.w; }
            float um2[8], um1[8];
            if (t0 > 0) { float x[8], y[8]; unpack8(rin[0], x); unpack8(rcc[0], y);
#pragma unroll
                for (int j = 0; j < 8; ++j) um2[j] = x[j] * y[j];
                unpack8(rin[1], x); unpack8(rcc[1], y);
#pragma unroll
                for (int j = 0; j < 8; ++j) um1[j] = x[j] * y[j]; }
            else if (samp) { const GAS float* cst = (const GAS float*)(INP(2) + ((size_t)l * BS + b) * 2 * DC) + c;
#pragma unroll
                for (int j = 0; j < 8; ++j) { um2[j] = cst[j]; um1[j] = cst[DC + j]; } }
            else {
#pragma unroll
                for (int j = 0; j < 8; ++j) { um2[j] = 0.f; um1[j] = 0.f; } }
            GAS float* cout = (GAS float*)out_ + (samp ? O_CONVS + ((size_t)l * BS + b) * 2 * DC : O_CONVP + ((size_t)l * BP + b) * 2 * DC) + c;
            const bool lastb = (t0 + 8 == T);
#pragma unroll
            for (int i = 0; i < 8; ++i) { float x[8], y[8], cb[8], u[8], o[8]; unpack8(rin[i + 2], x); unpack8(rcc[i + 2], y); unpack8(rcb[i], cb);
#pragma unroll
                for (int j = 0; j < 8; ++j) { u[j] = x[j] * y[j]; o[j] = cb[j] * (w0[j] * um2[j] + w1[j] * um1[j] + w2[j] * u[j]); um2[j] = um1[j]; um1[j] = u[j]; }
                *(GAS v4u*)(ACONV + (size_t)(m0 + i) * DC + c) = pack8(o);
                if (lastb && i >= 6) {
#pragma unroll
                    for (int j = 0; j < 8; ++j) cout[(size_t)(i - 6) * DC + j] = u[j]; } }
        } else {
            const int cl = (ch - 2) * 512 + lane * 8;
            if (cl < DSHIFT) {
                v4u rc[9];
                const GAS bf16* pm1 = (t0 > 0) ? p0 - DIN : (samp ? P + (size_t)(M + b) * DIN : nullptr);
                if (pm1) rc[0] = *(const GAS v4u*)(pm1 + OFF_R + cl); else rc[0] = (v4u){0u, 0u, 0u, 0u};
#pragma unroll
                for (int i = 0; i < 8; ++i) rc[i + 1] = *(const GAS v4u*)(p0 + (size_t)i * DIN + OFF_R + cl);
                float muv[8];
                { const f32x4 a0 = *(const GAS f32x4*)(mu + cl), a1 = *(const GAS f32x4*)(mu + cl + 4); muv[0] = a0.x; muv[1] = a0.y; muv[2] = a0.z; muv[3] = a0.w; muv[4] = a1.x; muv[5] = a1.y; muv[6] = a1.z; muv[7] = a1.w; }
                float prv[8]; unpack8(rc[0], prv);
#pragma unroll
                for (int i = 0; i < 8; ++i) { float cur[8], mx[8]; unpack8(rc[i + 1], cur);
#pragma unroll
                    for (int j = 0; j < 8; ++j) { mx[j] = cur[j] + muv[j] * (prv[j] - cur[j]); prv[j] = cur[j]; }
                    if (ch < 8) *(GAS v4u*)(RKV + (size_t)(m0 + i) * 3072 + cl) = pack8(mx);
                    else { const int q = cl - 3072;
                        if (q < 64) {
#pragma unroll
                            for (int j = 0; j < 8; ++j) mx[j] = tanhf(mx[j]);
                        } else if (q >= 128) {
#pragma unroll
                            for (int j = 0; j < 8; ++j) mx[j] = sigmoidf_(mx[j]);
                        }
                        *(GAS v4u*)(LL + (size_t)(m0 + i) * 256 + q) = pack8(mx); } }
            }
        }
    }
}

__device__ __forceinline__ void phase_zred(Frame& F) {
    const int lane = lane_id_asm();
    unsigned char* const ws_ = launder_s(F.ws);
    const int gw = launder_si(F.vcu * NWAVES + F.wave), NGW = F.G * NWAVES;
    const GAS bf16* P = (const GAS bf16*)(ws_ + WS_PU); GAS bf16* Z = (GAS bf16*)(ws_ + WS_RKV);
    const GAS bf16* SC_ = (const GAS bf16*)(ws_ + WS_WD); const GAS bf16* SR_ = (const GAS bf16*)(ws_ + WS_AA);
    for (int it = gw; it < MS * 4; it += NGW) {
        const int r = it >> 2, q = it & 3; const size_t m = (size_t)MP + r;
        { const int c = q * 512 + lane * 8;
            float gc[8], gr[8], sc[8], sr[8], o[8];
            const v4u gcw = *(const GAS v4u*)(P + m * DIN + OFF_GC + c), grw = *(const GAS v4u*)(P + m * DIN + OFF_GR + c);
            v4u ca[4], cb[4];
#pragma unroll
            for (int k4 = 0; k4 < 4; ++k4) { const size_t off = ((size_t)k4 * MS + r) * D + c; ca[k4] = *(const GAS v4u*)(SC_ + off); cb[k4] = *(const GAS v4u*)(SR_ + off); }
            unpack8(gcw, gc); unpack8(grw, gr);
#pragma unroll
            for (int j = 0; j < 8; ++j) { sc[j] = 0.f; sr[j] = 0.f; }
#pragma unroll
            for (int k4 = 0; k4 < 4; ++k4) { float pa[8], pb[8]; unpack8(ca[k4], pa); unpack8(cb[k4], pb);
#pragma unroll
                for (int j = 0; j < 8; ++j) { sc[j] += pa[j]; sr[j] += pb[j]; } }
#pragma unroll
            for (int j = 0; j < 8; ++j) o[j] = sigmoidf_(gc[j]) * sc[j] + sigmoidf_(gr[j]) * sr[j];
            *(GAS v4u*)(Z + m * D + c) = pack8(o); }
    }
}

constexpr int NCHUNK = BP * NH * (TP / 64) + BS * NH;
constexpr int CP = 72;
constexpr int L_QK = 0, L_RT = 9216, L_KT = 18432, L_BT = 27648, L_VT = 36864, L_KHT = 46080, L_BHT = 55296, L_LB = 64512, L_AKK = 73728, L_ARK = 82944, L_ARB = 92160,
              L_XF = 101376, XP = 68, L_LD = L_XF + 64 * XP * 4, L_WC = L_LD + 4096, L_GT = L_WC + 256, L_TB = L_GT + 2048, TBP = 40, L_END1 = L_TB + 64 * TBP * 2, ATP = 32;
static_assert(L_END1 <= RING_BYTES && 128 * ATP * 2 <= 9216, "scan1 LDS map");
typedef short bf16x8 __attribute__((ext_vector_type(8)));
__device__ __forceinline__ f32x4 mma16(bf16x8 a, bf16x8 b, f32x4 c) { return __builtin_amdgcn_mfma_f32_16x16x32_bf16(a, b, c, 0, 0, 0); }
__device__ __forceinline__ bf16x8 frag(const LAS bf16* base, int blk, int ks, int lane) { return *(const LAS bf16x8*)(base + (16 * blk + (lane & 15)) * CP + 32 * ks + 8 * (lane >> 4)); }
__device__ __forceinline__ v2u pack4(const f32x4 v) { v2u o; o.x = pk2(v[0], v[1]); o.y = pk2(v[2], v[3]); return o; }
__device__ __forceinline__ void chunk_coords(int cidx, int& m0, int& h) {
    if (cidx < BP * NH * 64) { const int b = cidx >> 10; h = (cidx >> 6) & 15; m0 = b * TP + (cidx & 63) * 64; }
    else { const int q = cidx - BP * NH * 64; h = q & 15; m0 = MP + (q >> 4) * TS; }
}

__device__ __forceinline__ void phase_scan1(Frame& F, int l) {
    const kptr_t ka = kargs(); const int lane0 = lane_id_asm(); (void)ka;
    unsigned char* const ws_ = launder_s(F.ws);
    LAS unsigned char* const B0 = F.lds + RING_OFF;
    LAS bf16* QK = launder_l((LAS bf16*)(B0 + L_QK)); LAS bf16* RT = launder_l((LAS bf16*)(B0 + L_RT)); LAS bf16* KT = launder_l((LAS bf16*)(B0 + L_KT)); LAS bf16* BT = KT + 64 * CP;
    LAS bf16* VT = launder_l((LAS bf16*)(B0 + L_VT)); LAS bf16* KHT = launder_l((LAS bf16*)(B0 + L_KHT)); LAS bf16* BHT = launder_l((LAS bf16*)(B0 + L_BHT));
    LAS bf16* LB = launder_l((LAS bf16*)(B0 + L_LB)); LAS bf16* AKK = launder_l((LAS bf16*)(B0 + L_AKK)); LAS bf16* ARK = launder_l((LAS bf16*)(B0 + L_ARK)); LAS bf16* ARB = launder_l((LAS bf16*)(B0 + L_ARB));
    LAS bf16* PT = KT; LAS bf16* U0T = BT;
    LAS float* XF = launder_l((LAS float*)(B0 + L_XF)); LAS float* LD = launder_l((LAS float*)(B0 + L_LD)); LAS float* WC = LD + 1024; LAS float* GT = WC + 64;
    LAS bf16* ACCT = AKK;
    LAS bf16* TBt = (LAS bf16*)(GT + 512);
    GAS bf16* RKV = (GAS bf16*)(ws_ + WS_RKV); GAS float* WD = (GAS float*)(ws_ + WS_WD); GAS bf16* AA = (GAS bf16*)(ws_ + WS_AA); GAS float* BON = (GAS float*)(ws_ + WS_LL);
    const GAS float* k_k = (const GAS float*)(INP(14) + (size_t)l * DC); const GAS float* k_a = (const GAS float*)(INP(15) + (size_t)l * DC); const GAS float* r_k = (const GAS float*)(INP(16) + (size_t)l * DC);
    const int w = F.wave, G = F.G;
    const int tm = w >> 1, tn0 = (w & 1) * 2;
#define STAGE_LANE const int lane = launder_v(lane0), fr = lane & 15, fq = lane >> 4, tid = w * 64 + lane; (void)fr; (void)fq; (void)tid
    { const int lane = launder_v(lane0); for (int i = w * 64 + lane; i < 64 * TBP * 2 / 4; i += NWAVES * 64) ((LAS unsigned*)TBt)[i] = 0u; }
    unsigned rvw[8], kvw[8], vvw[8], avw[8]; float lwv[8];
#define SCAN1_LOAD(ci) do { const int lane = launder_v(lane0); int m0_, h_; chunk_coords((ci), m0_, h_); \
        const GAS bf16* rp = RKV + (size_t)(m0_ + 8 * w) * 3072 + h_ * 64; const GAS float* wp = WD + (size_t)(m0_ + 8 * w) * DC + h_ * 64; const GAS bf16* ap = AA + (size_t)(m0_ + 8 * w) * DC + h_ * 64; \
        _Pragma("unroll") for (int i = 0; i < 8; ++i) { \
            rvw[i] = rp[i * 3072 + lane]; kvw[i] = rp[i * 3072 + 1024 + lane]; vvw[i] = rp[i * 3072 + 2048 + lane]; lwv[i] = wp[i * DC + lane]; avw[i] = ap[i * DC + lane]; } } while (0)
    for (int cidx = (int)blockIdx.x; cidx < NCHUNK; cidx += G) {
        int m0, h; chunk_coords(cidx, m0, h);
        if (cidx == (int)blockIdx.x) SCAN1_LOAD(cidx);
        float khv[8], bhv[8], rv[8], kv[8], vv[8], av[8];
#pragma unroll
        for (int i = 0; i < 8; ++i) { rv[i] = __builtin_bit_cast(float, rvw[i] << 16); kv[i] = __builtin_bit_cast(float, kvw[i] << 16); vv[i] = __builtin_bit_cast(float, vvw[i] << 16); av[i] = __builtin_bit_cast(float, avw[i] << 16); }
        {   STAGE_LANE; const int col = h * 64 + lane;
        float pre[8]; { float run = 0.f;
#pragma unroll
            for (int i = 0; i < 8; ++i) { run += lwv[i]; pre[i] = run; }
            GT[w * 64 + lane] = run; }
        lds_barrier();
        float offs = 0.f, tot = 0.f;
#pragma unroll
        for (int g = 0; g < 8; ++g) { const float x = GT[g * 64 + lane]; tot += x; offs += (g < w) ? x : 0.f; }
        const float kkc = k_k[col], kac = k_a[col], rkc = r_k[col]; float bonv = 0.f;
#pragma unroll
        for (int i = 0; i < 8; ++i) { const int t = 8 * w + i;
            const float kkr = kv[i] * kkc, ss = wave_sum(kkr * kkr), kk = kkr * __builtin_amdgcn_rsqf(fmaxf(ss, 1e-24f));
            const float kp = kv[i] * (1.0f + (av[i] - 1.0f) * kac), bb = kk * av[i];
            const float bon = wave_sum(rv[i] * kp * rkc);
            bonv = (lane == i) ? bon : bonv;
            const float cs = offs + pre[i], e_in = __expf(cs), e_ng = __builtin_amdgcn_rcpf(e_in), e_ex = __expf(cs - lwv[i]), e_h = __expf(tot - cs);
            QK[t * CP + lane] = (bf16)f2bf(kk * e_ex); RT[t * CP + lane] = (bf16)f2bf(rv[i] * e_in); KT[t * CP + lane] = (bf16)f2bf(kp * e_ng); BT[t * CP + lane] = (bf16)f2bf(bb * e_ng);
            khv[i] = kp * e_h; bhv[i] = bb * e_h; }
        { STAGE_LANE; *(LAS v4u*)(KHT + lane * CP + 8 * w) = pack8(khv); *(LAS v4u*)(BHT + lane * CP + 8 * w) = pack8(bhv); *(LAS v4u*)(VT + lane * CP + 8 * w) = pack8(vv); }
        if (w == 0) WC[lane] = __expf(tot);
        if (lane < 8) BON[(size_t)(m0 + 8 * w + lane) * NH + h] = bonv;
        }
        if (cidx + G < NCHUNK) SCAN1_LOAD(cidx + G);
        lds_barrier();
        {   STAGE_LANE; bf16x8 aq[2], ar[2];
#pragma unroll
            for (int ks = 0; ks < 2; ++ks) { aq[ks] = frag(QK, tm, ks, lane); ar[ks] = frag(RT, tm, ks, lane); }
#pragma unroll
            for (int q = 0; q < 2; ++q) { const int tn = tn0 + q;
                f32x4 aL = {0.f, 0.f, 0.f, 0.f}, aKK = aL, aRK = aL, aRB = aL;
#pragma unroll
                for (int ks = 0; ks < 2; ++ks) { const bf16x8 bb = frag(BT, tn, ks, lane), bk = frag(KT, tn, ks, lane);
                    aL = mma16(bb, aq[ks], aL); aKK = mma16(bk, aq[ks], aKK); aRK = mma16(bk, ar[ks], aRK); aRB = mma16(bb, ar[ks], aRB); }
                const int t = 16 * tm + fr, s0 = 16 * tn + 4 * fq;
                f32x4 mL, mKK, mRK, mRB, mD;
#pragma unroll
                for (int r = 0; r < 4; ++r) { const int sI = s0 + r; const bool lt = sI < t, le = sI <= t;
                    mKK[r] = lt ? aKK[r] : 0.f; mRK[r] = le ? aRK[r] : 0.f; mRB[r] = le ? aRB[r] : 0.f; mL[r] = (tn < tm) ? aL[r] : 0.f; mD[r] = lt ? aL[r] : 0.f; }
                *(LAS v2u*)(AKK + t * CP + s0) = pack4(mKK); *(LAS v2u*)(ARK + t * CP + s0) = pack4(mRK); *(LAS v2u*)(ARB + t * CP + s0) = pack4(mRB); *(LAS v2u*)(LB + t * CP + s0) = pack4(mL);
                if (tn == tm) *(LAS f32x4*)(LD + (tm * 16 + fr) * 16 + 4 * fq) = mD; }
        }
        lds_barrier();
        {   STAGE_LANE; bf16x8 a_[2];
#pragma unroll
            for (int ks = 0; ks < 2; ++ks) a_[ks] = frag(AKK, tm, ks, lane);
#pragma unroll
            for (int q = 0; q < 2; ++q) { const int tn = tn0 + q; f32x4 acc = {0.f, 0.f, 0.f, 0.f};
#pragma unroll
                for (int ks = 0; ks < 2; ++ks) acc = mma16(frag(VT, tn, ks, lane), a_[ks], acc);
                *(LAS f32x4*)(XF + (16 * tm + fr) * XP + 16 * tn + 4 * fq) = acc; }
            if (w == 0) { const int bb = lane >> 4, cc = lane & 15; float x[16];
                f32x4 Lr[16][4];
#pragma unroll
                for (int t = 1; t < 16; ++t)
#pragma unroll
                    for (int q4 = 0; q4 < (t + 3) / 4; ++q4) Lr[t][q4] = *(const LAS f32x4*)(LD + (bb * 16 + t) * 16 + 4 * q4);
#pragma unroll
                for (int t = 0; t < 16; ++t) { float acc = (t == cc) ? 1.f : 0.f;
#pragma unroll
                    for (int sI = 0; sI < t; ++sI) acc -= Lr[t][sI >> 2][sI & 3] * x[sI];
                    x[t] = acc; }
#pragma unroll
                for (int t = 0; t < 16; ++t) TBt[(bb * 16 + t) * TBP + cc] = (bf16)f2bf(x[t]); }
        }
        lds_barrier();
        {   STAGE_LANE; unsigned zz = 0u; asm volatile("" : "+v"(zz));
            for (int i = lane; i < 16 * CP * 2 / 16; i += 64) ((LAS v4u*)(PT + 16 * w * CP))[i] = (v4u){zz, zz, zz, zz};
            if (lane < 32) *(LAS v4u*)(ACCT + (16 * w + (lane >> 1)) * ATP + 16 + 8 * (lane & 1)) = (v4u){zz, zz, zz, zz}; asm volatile("" ::: "memory");
#pragma unroll
            for (int i = 0; i < 4; ++i) {
                f32x4 acc = {0.f, 0.f, 0.f, 0.f};
#pragma unroll
                for (int ks = 0; ks < (i + 1) / 2; ++ks) acc = mma16(frag(PT, w, ks, lane), frag(LB, i, ks, lane), acc);
                const int c0 = 16 * w + 4 * fq;
                f32x4 rhs;
                if (w < 4) { const v2u qv = *(const LAS v2u*)(QK + (16 * i + fr) * CP + c0); rhs = (f32x4){bf_lo(qv.x), bf_hi(qv.x), bf_lo(qv.y), bf_hi(qv.y)}; }
                else rhs = *(const LAS f32x4*)(XF + (16 * i + fr) * XP + c0 - 64);
                rhs = rhs - acc;
#pragma unroll
                for (int r = 0; r < 4; ++r) ACCT[(c0 + r) * ATP + fr] = (bf16)f2bf(rhs[r]);
                asm volatile("" ::: "memory");
                const bf16x8 ta = *(const LAS bf16x8*)(TBt + (16 * i + fr) * TBP + 8 * fq), tb = *(const LAS bf16x8*)(ACCT + (16 * w + fr) * ATP + 8 * fq);
                const f32x4 o = mma16(ta, tb, (f32x4){0.f, 0.f, 0.f, 0.f});
                *(LAS v2u*)(PT + (16 * w + fr) * CP + 16 * i + 4 * fq) = pack4(o);
                asm volatile("" ::: "memory");
            }
        }
        lds_barrier();
        {   STAGE_LANE; bf16x8 aRK[2], aRB[2], aPT[2], aVT[2], aU0[2];
#pragma unroll
            for (int ks = 0; ks < 2; ++ks) { aRK[ks] = frag(ARK, tm, ks, lane); aRB[ks] = frag(ARB, tm, ks, lane); aPT[ks] = frag(PT, tm, ks, lane); aVT[ks] = frag(VT, tm, ks, lane); aU0[ks] = frag(U0T, tm, ks, lane); }
#pragma unroll
            for (int q = 0; q < 2; ++q) { const int tn = tn0 + q; const f32x4 z = {0.f, 0.f, 0.f, 0.f};
                f32x4 y0a = z, y0b = z, qh = z, mc = z, nca = z, ncb = z;
#pragma unroll
                for (int ks = 0; ks < 2; ++ks) { const bf16x8 bVT = frag(VT, tn, ks, lane), bU0 = frag(U0T, tn, ks, lane), bPT = frag(PT, tn, ks, lane), bBH = frag(BHT, tn, ks, lane), bKH = frag(KHT, tn, ks, lane);
                    y0a = mma16(bVT, aRK[ks], y0a); y0b = mma16(bU0, aRB[ks], y0b); qh = mma16(bPT, aRB[ks], qh); mc = mma16(aPT[ks], bBH, mc); nca = mma16(bKH, aVT[ks], nca); ncb = mma16(bBH, aU0[ks], ncb); }
                const int row = 16 * tm + fr, c0 = 16 * tn + 4 * fq; const size_t mrow = (size_t)(m0 + row);
                *(GAS v2u*)(RKV + mrow * 3072 + h * 64 + c0) = pack4(y0a - y0b);
                { const v2u rt = *(const LAS v2u*)(RT + row * CP + c0); const f32x4 rtf = {bf_lo(rt.x), bf_hi(rt.x), bf_lo(rt.y), bf_hi(rt.y)};
                  *(GAS v2u*)(RKV + mrow * 3072 + 1024 + h * 64 + c0) = pack4(rtf - qh); }
                { const int jj = 16 * tn + fr, i0m = 16 * tm + 4 * fq; const float wc = WC[jj]; f32x4 d;
#pragma unroll
                  for (int r = 0; r < 4; ++r) d[r] = ((i0m + r == jj) ? wc : 0.f) - mc[r];
                  *(GAS v2u*)((GAS bf16*)WD + (size_t)(m0 + jj) * 2048 + h * 128 + i0m) = pack4(d); }
                *(GAS v2u*)(AA + mrow * DC + h * 64 + c0) = pack4(nca - ncb); }
        }
        lds_barrier();
    }
}

__device__ __forceinline__ void phase_scan2(Frame& F, int l) {
    const kptr_t ka = kargs(); const int lane = lane_id_asm(), tid = F.wave * 64 + lane; (void)ka;
    unsigned char* const ws_ = launder_s(F.ws); float* const out_ = launder_s(F.out);
    LAS bf16* MT = launder_l((LAS bf16*)(F.lds + RING_OFF));
    LAS float* NB = (LAS float*)(MT + 2 * 64 * CP);
    LAS bf16* SH = (LAS bf16*)(NB + 2 * 1024);
    LAS bf16* SL = SH + 16 * CP;
    const GAS bf16* WDb = (const GAS bf16*)(ws_ + WS_WD); const GAS bf16* AAb = (const GAS bf16*)(ws_ + WS_AA); GAS bf16* SC = (GAS bf16*)(ws_ + WS_HB);
    const int G = F.G, w = F.wave, fr = lane & 15, fq = lane >> 4;
    const int mrow = tid >> 3, mc8 = (tid & 7) * 8;
    constexpr int NPI = BP * NH * 4, NSI = BS * NH * 4;
    for (int item = (int)blockIdx.x; item < NPI + NSI; item += G) {
        const bool samp = item >= NPI; const int q = samp ? item - NPI : item, seq = q >> 2, rq = q & 3, b = seq >> 4, h = seq & 15;
        const int nch = samp ? 1 : TP / 64, cidx0 = samp ? BP * NH * 64 + seq : seq * 64, m0 = samp ? MP + b * TS : b * TP;
        f32x4 sD = {0.f, 0.f, 0.f, 0.f};
        if (samp && w < 4) { const GAS float* sp = (const GAS float*)(INP(4) + ((((size_t)l * BS + b) * NH + h) * HD + rq * 16 + 4 * fq) * HD + 16 * w + fr);
#pragma unroll
            for (int r = 0; r < 4; ++r) sD[r] = sp[r * 64]; }
#define S2_SPLIT() do { if (w < 4) { _Pragma("unroll") for (int r = 0; r < 4; ++r) { const unsigned hb = f2bf(sD[r]); const float lo = sD[r] - bf_lo(hb); \
            SH[(4 * fq + r) * CP + 16 * w + fr] = (bf16)hb; SL[(4 * fq + r) * CP + 16 * w + fr] = (bf16)f2bf(lo); } } } while (0)
        S2_SPLIT();
        v4u am, an, bm, bn, cm, cn, dm, dn;
#define S2_LOAD(st, M_, N_) do { if ((st) < nch) { const size_t mb_ = (size_t)(m0 + (st) * 64); \
            M_ = *(const GAS v4u*)(WDb + (mb_ + mrow) * 2048 + h * 128 + mc8); \
            if (tid < 128) N_ = *(const GAS v4u*)(AAb + (mb_ + rq * 16 + mrow) * DC + h * 64 + mc8); } } while (0)
#define S2_STORE(buf, M_, N_) do { *(LAS v4u*)(MT + (buf) * 64 * CP + mrow * CP + mc8) = M_; \
            if (tid < 128) { LAS float* np_ = NB + (buf) * 1024 + mrow * 64 + mc8; \
                *(LAS f32x4*)np_ = (f32x4){bf_lo(N_.x), bf_hi(N_.x), bf_lo(N_.y), bf_hi(N_.y)}; *(LAS f32x4*)(np_ + 4) = (f32x4){bf_lo(N_.z), bf_hi(N_.z), bf_lo(N_.w), bf_hi(N_.w)}; } } while (0)
        S2_LOAD(0, am, an); S2_LOAD(1, bm, bn); S2_LOAD(2, cm, cn); S2_LOAD(3, dm, dn);
        S2_STORE(0, am, an);
        S2_LOAD(4, am, an);
        lds_barrier();
#define S2_STEP(c, M_, N_) do { \
            if ((c) + 1 < nch) S2_STORE(((c) + 1) & 1, M_, N_); \
            S2_LOAD((c) + 5, M_, N_); \
            if (w < 4) { GAS bf16* scp = SC + ((size_t)(cidx0 + (c)) * 64 + rq * 16 + 4 * fq) * 64 + 16 * w + fr; \
                _Pragma("unroll") for (int r = 0; r < 4; ++r) scp[r * 64] = (bf16)f2bf(sD[r]); \
                const LAS bf16* Mt = MT + ((c) & 1) * 64 * CP; const LAS float* Nc = NB + ((c) & 1) * 1024; \
                f32x4 acc; _Pragma("unroll") for (int r = 0; r < 4; ++r) acc[r] = Nc[(4 * fq + r) * 64 + 16 * w + fr]; \
                _Pragma("unroll") for (int ks = 0; ks < 2; ++ks) { const bf16x8 bm_ = frag(Mt, w, ks, lane); \
                    acc = mma16(frag(SH, 0, ks, lane), bm_, acc); acc = mma16(frag(SL, 0, ks, lane), bm_, acc); } \
                sD = acc; } \
            lds_barrier(); \
            S2_SPLIT(); \
            lds_barrier(); } while (0)
        for (int c = 0; c < nch; c += 4) {
            S2_STEP(c, bm, bn); if (c + 1 >= nch) break;
            S2_STEP(c + 1, cm, cn); if (c + 2 >= nch) break;
            S2_STEP(c + 2, dm, dn); if (c + 3 >= nch) break;
            S2_STEP(c + 3, am, an);
        }
#undef S2_STEP
#undef S2_LOAD
#undef S2_STORE
#undef S2_SPLIT
        if (w < 4) { GAS float* so = (GAS float*)out_ + (samp ? O_WKVS + ((((size_t)l * BS + b) * NH + h) * HD + rq * 16 + 4 * fq) * HD : O_WKVP + ((((size_t)l * BP + b) * NH + h) * HD + rq * 16 + 4 * fq) * HD) + 16 * w + fr;
#pragma unroll
            for (int r = 0; r < 4; ++r) so[r * 64] = sD[r]; }
    }
}

__device__ __forceinline__ void phase_scan3(Frame& F, int l) {
    const kptr_t ka = kargs(); const int lane = lane_id_asm(), tid = F.wave * 64 + lane; (void)ka;
    unsigned char* const ws_ = launder_s(F.ws);
    LAS bf16* QH = launder_l((LAS bf16*)(F.lds + RING_OFF)); LAS bf16* SCB = QH + 64 * CP; LAS float* YF = (LAS float*)(QH + 2 * 64 * CP); constexpr int YP = 68;
    const GAS bf16* RKV = (const GAS bf16*)(ws_ + WS_RKV); const GAS bf16* SC = (const GAS bf16*)(ws_ + WS_HB); const GAS bf16* GG = (const GAS bf16*)(ws_ + WS_GG); const GAS float* BON = (const GAS float*)(ws_ + WS_LL);
    GAS bf16* ARWKV = (GAS bf16*)(ws_ + WS_ARWKV);
    const GAS float* lnw = (const GAS float*)(INP(17) + (size_t)l * DC); const GAS float* lnb = (const GAS float*)(INP(18) + (size_t)l * DC);
    const int w = F.wave, G = F.G, tok = tid >> 3, sg = tid & 7, tm = w >> 1, tn0 = (w & 1) * 2, fr = lane & 15, fq = lane >> 4;
    v4u pqh, psc, py0, pv, pg; float pbon;
#define S3_LOAD(ci) do { int m0_, h_; chunk_coords((ci), m0_, h_); const size_t m_ = (size_t)(m0_ + tok); const int col_ = h_ * 64 + sg * 8; \
        pqh = *(const GAS v4u*)(RKV + m_ * 3072 + 1024 + col_); psc = *(const GAS v4u*)(SC + ((size_t)(ci) * 64 + tok) * 64 + sg * 8); \
        py0 = *(const GAS v4u*)(RKV + m_ * 3072 + col_); pv = *(const GAS v4u*)(RKV + m_ * 3072 + 2048 + col_); pg = *(const GAS v4u*)(GG + m_ * DC + col_); pbon = BON[m_ * NH + h_]; } while (0)
    if ((int)blockIdx.x < NCHUNK) S3_LOAD((int)blockIdx.x);
    for (int cidx = (int)blockIdx.x; cidx < NCHUNK; cidx += G) {
        int m0, h; chunk_coords(cidx, m0, h);
        const size_t m = (size_t)(m0 + tok); const int col = h * 64 + sg * 8;
        *(LAS v4u*)(QH + tok * CP + sg * 8) = pqh; *(LAS v4u*)(SCB + tok * CP + sg * 8) = psc;
        const v4u y0w = py0, vw = pv, gw = pg; const float bon = pbon;
        lds_barrier();
        if (cidx + G < NCHUNK) S3_LOAD(cidx + G);
        {   bf16x8 a_[2];
#pragma unroll
            for (int ks = 0; ks < 2; ++ks) a_[ks] = frag(QH, tm, ks, lane);
#pragma unroll
            for (int q = 0; q < 2; ++q) { const int tn = tn0 + q; f32x4 acc = {0.f, 0.f, 0.f, 0.f};
#pragma unroll
                for (int ks = 0; ks < 2; ++ks) acc = mma16(frag(SCB, tn, ks, lane), a_[ks], acc);
                *(LAS f32x4*)(YF + (16 * tm + fr) * YP + 16 * tn + 4 * fq) = acc; }
        }
        lds_barrier();
        {   float y[8], y0[8], vv[8], g[8], ov[8]; unpack8(y0w, y0); unpack8(vw, vv); unpack8(gw, g);
            const f32x4 ya = *(const LAS f32x4*)(YF + tok * YP + sg * 8), yb = *(const LAS f32x4*)(YF + tok * YP + sg * 8 + 4);
            y[0] = ya[0] + y0[0]; y[1] = ya[1] + y0[1]; y[2] = ya[2] + y0[2]; y[3] = ya[3] + y0[3]; y[4] = yb[0] + y0[4]; y[5] = yb[1] + y0[5]; y[6] = yb[2] + y0[6]; y[7] = yb[3] + y0[7];
            float s_ = 0.f;
#pragma unroll
            for (int j = 0; j < 8; ++j) s_ += y[j];
            const float mean = sum8(s_) * (1.f / 64.f); float qv = 0.f;
#pragma unroll
            for (int j = 0; j < 8; ++j) { y[j] -= mean; qv += y[j] * y[j]; }
            const float rstd = __builtin_amdgcn_rsqf(sum8(qv) * (1.f / 64.f) + GN_EPS);
#pragma unroll
            for (int j = 0; j < 8; ++j) ov[j] = (y[j] * rstd * lnw[col + j] + lnb[col + j] + bon * vv[j]) * g[j];
            *(GAS v4u*)(ARWKV + m * DC + col) = pack8(ov);
        }
        lds_barrier();
    }
#undef S3_LOAD
}

constexpr int NPH = 13;
constexpr int NSTEPS = 1 + NL * NPH + 1;
__global__ void __launch_bounds__(NWAVES * 64, 2) trunk_fwd(Args args) {
    extern __shared__ __attribute__((aligned(16))) unsigned char lds[];
    Frame F;
    F.lds = (LAS unsigned char*)lds;
    F.wave = __builtin_amdgcn_readfirstlane((int)threadIdx.x >> 6);
    F.G = gridDim.x; { const int bx = blockIdx.x; F.vcu = launder_si((F.G % 8 == 0) ? (bx % 8) * (F.G / 8) + bx / 8 : bx); }
    F.out = args.out; F.ws = args.ws;
    volatile LAS unsigned* MISC = (volatile LAS unsigned*)(F.lds + MISC_OFF);
    for (int u = threadIdx.x; u < (LDS_BYTES - LDSCTL_OFF) / 4; u += NWAVES * 64) ((LAS unsigned*)(F.lds + LDSCTL_OFF))[u] = 0u;
    __syncthreads();
    const int lo = args.st_lo, hi = args.st_hi;
    const bool use_bar = (hi - lo) > 1;
    unsigned* barw = (unsigned*)(F.ws + WS_CTL) + CW_BAR;
    XcdBarrier bar; bar.bar = barw; bar.x = 0; bar.st = nullptr; bar.wave = F.wave;
    if (use_bar) bar = xcd_barrier_post(barw, MISC + 8, F.wave);
#define IN(k) (lo <= (k) && (k) < hi)
#define SEAM(k) do { if (IN(k) && IN((k) + 1)) xcd_barrier(bar); } while (0)
    PG8_LAS unsigned char* ring = F.lds + RING_OFF;
    const int bx = (int)blockIdx.x;

    if (IN(0)) { phase_prologue(F); } SEAM(0);
#define WSL const int l = launder_si(lq); unsigned char* ws = launder_s(F.ws); bf16* HB = (bf16*)(ws + WS_HB); bf16* PU = (bf16*)(ws + WS_PU); bf16* Z = (bf16*)(ws + WS_RKV); (void)HB; (void)PU; (void)Z
    for (int lq = 0; lq < NL; ++lq) {
        const int s0 = 1 + lq * NPH;
        if (IN(s0 + 0)) phase_norm(F, launder_si(lq), 0);
        SEAM(s0 + 0);
        if (IN(s0 + 1)) { WSL; pg8::Gemm g{HB, (const bf16*)(ws + WS_WIN + l * SZ_WIN), MA, DIN, D}; pg8::Order S; S.init(M / 256, DIN / 256, F.G, bx, D, 13, OFF_R / 256);
            pg8::EpiBf16 E{(GAS bf16*)PU, DIN, 0}; pg8::gemm_phase<pg8::EpiBf16, pg8::Order, true, true>(ring, g, S, E, F.wave); }
        SEAM(s0 + 1);
        if (IN(s0 + 2)) phase_mix(F, launder_si(lq));
        SEAM(s0 + 2);
        if (IN(s0 + 3)) { WSL; const kptr_t ka = kargs(); pg8::Gemm g{(const bf16*)(ws + WS_LL), (const bf16*)(ws + WS_WLORA + l * SZ_WLORA), M, 3072, 256}; pg8::Order S; S.init(M / 256, 12, F.G, bx, 256);
            pg8::EpiLora E{(GAS float*)(ws + WS_WD), (GAS bf16*)(ws + WS_AA), (GAS bf16*)(ws + WS_GG), (const GAS float*)(INP(9) + (size_t)l * DC), (const GAS float*)(INP(11) + (size_t)l * DC)};
            pg8::gemm_phase<pg8::EpiLora, pg8::Order, true, true>(ring, g, S, E, F.wave); }
        SEAM(s0 + 3);
        if (IN(s0 + 4)) phase_scan1(F, launder_si(lq));
        SEAM(s0 + 4);
        if (IN(s0 + 5)) phase_scan2(F, launder_si(lq));
        SEAM(s0 + 5);
        if (IN(s0 + 6)) phase_scan3(F, launder_si(lq));
        SEAM(s0 + 6);
        if (IN(s0 + 7)) { WSL; pg8::Gemm g{(const bf16*)(ws + WS_ACONV), (const bf16*)(ws + WS_WOC + l * SZ_WOC), M, D, DC}; pg8::Order S; S.init(MP / 256, D / 256, F.G, bx, DC, (MS / 256) * (D / 256) * 4, 0, 4, 4, 0);
            pg8::EpiGate E{(GAS bf16*)Z, (const GAS bf16*)(PU + OFF_GC), DIN, 0, (GAS bf16*)(ws + WS_WD), MP}; pg8::gemm_phase<pg8::EpiGate, pg8::Order, true, true>(ring, g, S, E, F.wave); }
        if (IN(s0 + 7)) { WSL; pg8::Gemm g{(const bf16*)(ws + WS_ARWKV), (const bf16*)(ws + WS_WOR + l * SZ_WOC), M, D, DC}; pg8::Order S; S.init(MP / 256, D / 256, F.G, bx, DC, (MS / 256) * (D / 256) * 4, 0, 4, 4, F.G / 2);
            pg8::EpiGate E{(GAS bf16*)Z, (const GAS bf16*)(PU + OFF_GR), DIN, 1, (GAS bf16*)(ws + WS_AA), MP}; pg8::gemm_phase<pg8::EpiGate, pg8::Order, true, true>(ring, g, S, E, F.wave); }
        SEAM(s0 + 7);
        if (IN(s0 + 8)) phase_zred(F);
        SEAM(s0 + 8);
        if (IN(s0 + 9)) { WSL; pg8::Gemm g{Z, (const bf16*)(ws + WS_WO + l * SZ_WO), M, D, D}; pg8::Order S; S.init(MP / 256, D / 256, F.G, bx, D, (MS / 256) * (D / 256) * 8, 0, 8);
            GAS bf16* XB = (GAS bf16*)launder_s(F.out); pg8::EpiRes E{XB, XB, D, (GAS bf16*)(ws + WS_WD), MP}; pg8::gemm_phase<pg8::EpiRes, pg8::Order, true, true>(ring, g, S, E, F.wave); }
        SEAM(s0 + 9);
        if (IN(s0 + 10)) phase_norm(F, launder_si(lq), 1);
        SEAM(s0 + 10);
        if (IN(s0 + 11)) { WSL; pg8::Gemm g{HB, (const bf16*)(ws + WS_WUP + l * SZ_WUP), M, DFF, D}; pg8::Order S; S.init(M / 256, DFF / 256, F.G, bx, D);
            pg8::EpiBf16 E{(GAS bf16*)PU, DFF, 1}; pg8::gemm_phase<pg8::EpiBf16, pg8::Order, true, true>(ring, g, S, E, F.wave); }
        SEAM(s0 + 11);
        if (IN(s0 + 12)) { WSL; pg8::Gemm g{PU, (const bf16*)(ws + WS_WDN + l * SZ_WUP), M, D, DFF}; pg8::Order S; S.init(MP / 256, D / 256, F.G, bx, DFF, (MS / 256) * (D / 256) * 8, 0, 8);
            GAS bf16* XB = (GAS bf16*)launder_s(F.out); GAS bf16* XO = (l == NL - 1) ? (GAS bf16*)(ws + WS_RKV) : XB;
            pg8::EpiRes E{XB, XO, D, (GAS bf16*)(ws + WS_WD), MP}; pg8::gemm_phase<pg8::EpiRes, pg8::Order, true, true>(ring, g, S, E, F.wave); }
        SEAM(s0 + 12);
    }
    { const int lo2 = launder_si(lo), hi2 = launder_si(hi); if (lo2 <= NSTEPS - 1 && NSTEPS - 1 < hi2) phase_norm(F, 0, 2); }
#undef IN
#undef SEAM
}

extern "C" void kernel_launch(void* const* d_in, const int* in_sizes, int n_in, void* d_out, int out_size, void* d_ws, size_t ws_size, hipStream_t stream) {
    static int grid = 0;
    if (grid == 0) {
        if (n_in != 26 || (size_t)out_size != O_END || ws_size < WS_END) { fprintf(stderr, "kernel_launch: shape mismatch n_in %d out %d ws %zu (need %zu)\n", n_in, out_size, ws_size, (size_t)WS_END); grid = -1; return; }
        int dev = 0, cus = 0, per_cu = 0;
        if (hipGetDevice(&dev) != hipSuccess || hipDeviceGetAttribute(&cus, hipDeviceAttributeMultiprocessorCount, dev) != hipSuccess) { grid = -1; return; }
        if (hipFuncSetAttribute((const void*)trunk_fwd, hipFuncAttributeMaxDynamicSharedMemorySize, LDS_BYTES) != hipSuccess) { fprintf(stderr, "kernel_launch: hipFuncSetAttribute failed\n"); grid = -1; return; }
        if (hipOccupancyMaxActiveBlocksPerMultiprocessor(&per_cu, (const void*)trunk_fwd, NWAVES * 64, LDS_BYTES) != hipSuccess || per_cu < 1)
            fprintf(stderr, "kernel_launch: occupancy query reports %d workgroups per CU\n", per_cu);
        (void)hipGetLastError();
        grid = cus;
    }
    if (grid < 0) return;
    if (hipMemsetAsync((char*)d_ws + WS_CTL, 0, CTL_ZERO_BYTES, stream) != hipSuccess) return;
    Args a{};
    for (int i = 0; i < 26; ++i) a.in[i] = (const float*)d_in[i];
    a.out = (float*)d_out; a.ws = (unsigned char*)d_ws;
#if MK_ONE_LAUNCH
    a.st_lo = 0; a.st_hi = NSTEPS;
    hipLaunchKernelGGL(trunk_fwd, dim3(grid), dim3(NWAVES * 64), LDS_BYTES, stream, a);
#else
    for (int s = 0; s < NSTEPS; ++s) {
        a.st_lo = s; a.st_hi = s + 1;
        hipLaunchKernelGGL(trunk_fwd, dim3(grid), dim3(NWAVES * 64), LDS_BYTES, stream, a);
    }
#endif
}
```

```cpp
#include <hip/hip_runtime.h>
#include <cstdio>
#include <cstdint>

#ifndef MK_ONE_LAUNCH
#define MK_ONE_LAUNCH 1
#endif

__device__ __forceinline__ int lane_id_asm() { int v; asm volatile("v_mbcnt_lo_u32_b32 %0, -1, 0\n\tv_mbcnt_hi_u32_b32 %0, -1, %0" : "=v"(v)); return v; }

namespace pg8 {
#define PG8_LAS __attribute__((address_space(3)))
#define PG8_GAS __attribute__((address_space(1)))
typedef unsigned short bf16_t;
typedef short bf16x8 __attribute__((ext_vector_type(8)));
typedef float f32x4 __attribute__((ext_vector_type(4)));
typedef unsigned u32x4 __attribute__((ext_vector_type(4)));
typedef unsigned u32x2 __attribute__((ext_vector_type(2)));
constexpr int BM = 256, BK = 64, HALF = 128, HTB = HALF * BK * 2, STAGE_BYTES = 8 * HTB, NXCD = 8;

__host__ __device__ __forceinline__ int lds_byte(int r, int c) { const int st = (r >> 4) * 2 + (c >> 5), rr = r & 15, cc = c & 31, ob = rr * 64 + cc * 2; return st * 1024 + (ob ^ (((ob >> 9) & 1) << 5)); }
__host__ __device__ __forceinline__ void stage_rc(int b, int& R, int& C) { const int st = b / 1024, sb = b % 1024, swz = sb ^ (((sb >> 9) & 1) << 5); R = (st >> 1) * 16 + swz / 64; C = (st & 1) * 32 + (swz % 64) / 2; }
__host__ __device__ __forceinline__ int perm32(int rho) { const int n = rho >> 4, i = rho & 15; return 8 * (i >> 2) + 4 * n + (i & 3); }

struct Unit { int pm, pn, kt0, nkt, ks; };
struct Gemm { const bf16_t* A; const bf16_t* Bt; int M, N, K; };

struct Order {
    int nM, nN, nwg, G, c, nX, x0, nktf, sk, WGM, xoff;
    __device__ void init(int nM_, int nN_, int G_, int c_, int K_, int nX_ = 0, int x0_ = 0, int sk_ = 0, int wgm_ = 4, int xoff_ = 0) { WGM = wgm_; xoff = xoff_; nM = nM_; nN = nN_; nwg = nM * nN; G = G_; c = c_; nX = nX_; x0 = x0_; nktf = K_ / BK; sk = sk_; }
    __device__ bool next(int i, Unit& u) const {
        const long L = (long)i * G + c; if (L >= nwg + nX + xoff) return false;
        u.kt0 = 0; u.nkt = nktf; u.ks = -1;
        if (L >= nwg) { const int j = (int)(L - nwg) - xoff; if (j < 0) return false;
            if (sk) { const int uu = j / sk; u.ks = j % sk; u.pm = nM + uu / nN; u.pn = uu % nN; u.nkt = nktf / sk; u.kt0 = u.ks * u.nkt; }
            else { u.pm = nM; u.pn = x0 + j; }
            return true; }
        int wgid = (int)L; { const int q = nwg / NXCD, r = nwg % NXCD, xcd = wgid % NXCD, off = wgid / NXCD; wgid = (xcd < r ? xcd * (q + 1) : r * (q + 1) + (xcd - r) * q) + off; }
        const int nig = WGM * nN, gid = wgid / nig, fm = gid * WGM, gsz = (nM - fm) < WGM ? (nM - fm) : WGM;
        u.pm = fm + ((wgid % nig) % gsz); u.pn = (wgid % nig) / gsz; return true;
    }
    __device__ __forceinline__ void a_ready(const Unit&) const {}
    __device__ __forceinline__ void done(const Unit&) const {}
};

typedef float f32x2c __attribute__((ext_vector_type(2)));
typedef __bf16 bf16x2c __attribute__((ext_vector_type(2)));
__device__ __forceinline__ unsigned cvt_pk_bf16(float lo, float hi) { const f32x2c f = {lo, hi}; return __builtin_bit_cast(unsigned, __builtin_convertvector(f, bf16x2c)); }
__device__ __forceinline__ float bf_lo(unsigned w) { return __builtin_bit_cast(float, w << 16); }
__device__ __forceinline__ float bf_hi(unsigned w) { return __builtin_bit_cast(float, w & 0xffff0000u); }
__device__ __forceinline__ float sigmoidf_(float x) { return __builtin_amdgcn_rcpf(1.0f + __expf(-x)); }

struct EpiBf16 {
    static constexpr bool PERM = true, AFTER_DRAIN = false;
    PG8_GAS bf16_t* O; int ldc; int act;
    __device__ __forceinline__ void operator()(const f32x4 (&acc)[2][2][4][2], const Unit& u, int wr, int wc, int fr, int fq) const {
        { const int l_ = lane_id_asm(); fr = l_ & 15; fq = l_ >> 4; }
        const int row0 = u.pm * BM + wr * 64 + fr, col0 = u.pn * BM + wc * 32 + 8 * fq;
#pragma unroll
        for (int ai = 0; ai < 2; ++ai)
#pragma unroll
            for (int m = 0; m < 4; ++m) { PG8_GAS bf16_t* rowp = O + (size_t)(row0 + ai * HALF + m * 16) * ldc + col0;
#pragma unroll
                for (int bj = 0; bj < 2; ++bj) { f32x4 v0 = acc[ai][bj][m][0], v1 = acc[ai][bj][m][1];
                    if (act) {
#pragma unroll
                        for (int j = 0; j < 4; ++j) { const float a = fmaxf(v0[j], 0.f), b = fmaxf(v1[j], 0.f); v0[j] = a * a; v1[j] = b * b; } }
                    u32x4 w; w.x = cvt_pk_bf16(v0[0], v0[1]); w.y = cvt_pk_bf16(v0[2], v0[3]); w.z = cvt_pk_bf16(v1[0], v1[1]); w.w = cvt_pk_bf16(v1[2], v1[3]);
                    *(PG8_GAS u32x4*)(rowp + bj * HALF) = w; } }
    }
};
struct EpiRes {
    static constexpr bool PERM = true, AFTER_DRAIN = false;
    const PG8_GAS bf16_t* Xin; PG8_GAS bf16_t* Xout; int ldc; PG8_GAS bf16_t* SL; int row0s;
    __device__ __forceinline__ void operator()(const f32x4 (&acc)[2][2][4][2], const Unit& u, int wr, int wc, int fr, int fq) const {
        { const int l_ = lane_id_asm(); fr = l_ & 15; fq = l_ >> 4; }
        const int row0 = u.pm * BM + wr * 64 + fr, col0 = u.pn * BM + wc * 32 + 8 * fq;
        if (u.ks >= 0) {
            PG8_GAS bf16_t* base = SL + ((size_t)u.ks * 1024 + (row0 - row0s)) * ldc + col0;
#pragma unroll
            for (int ai = 0; ai < 2; ++ai)
#pragma unroll
                for (int m = 0; m < 4; ++m)
#pragma unroll
                    for (int bj = 0; bj < 2; ++bj) { const f32x4 v0 = acc[ai][bj][m][0], v1 = acc[ai][bj][m][1];
                        u32x4 w; w.x = cvt_pk_bf16(v0[0], v0[1]); w.y = cvt_pk_bf16(v0[2], v0[3]); w.z = cvt_pk_bf16(v1[0], v1[1]); w.w = cvt_pk_bf16(v1[2], v1[3]);
                        *(PG8_GAS u32x4*)(base + (size_t)(ai * HALF + m * 16) * ldc + bj * HALF) = w; }
            return;
        }
#pragma unroll
        for (int ai = 0; ai < 2; ++ai) {
            u32x4 xv[4][2];
#pragma unroll
            for (int m = 0; m < 4; ++m)
#pragma unroll
                for (int bj = 0; bj < 2; ++bj) xv[m][bj] = *(const PG8_GAS u32x4*)(Xin + (size_t)(row0 + ai * HALF + m * 16) * ldc + col0 + bj * HALF);
#pragma unroll
            for (int m = 0; m < 4; ++m)
#pragma unroll
                for (int bj = 0; bj < 2; ++bj) { const u32x4 x = xv[m][bj]; const f32x4 v0 = acc[ai][bj][m][0], v1 = acc[ai][bj][m][1];
                    u32x4 w; w.x = cvt_pk_bf16(bf_lo(x.x) + v0[0], bf_hi(x.x) + v0[1]); w.y = cvt_pk_bf16(bf_lo(x.y) + v0[2], bf_hi(x.y) + v0[3]);
                    w.z = cvt_pk_bf16(bf_lo(x.z) + v1[0], bf_hi(x.z) + v1[1]); w.w = cvt_pk_bf16(bf_lo(x.w) + v1[2], bf_hi(x.w) + v1[3]);
                    *(PG8_GAS u32x4*)(Xout + (size_t)(row0 + ai * HALF + m * 16) * ldc + col0 + bj * HALF) = w; }
            asm volatile("" ::: "memory"); }
    }
};
struct EpiGate {
    static constexpr bool PERM = true, AFTER_DRAIN = false;
    PG8_GAS bf16_t* Z; const PG8_GAS bf16_t* Pg; int ldp; int add; PG8_GAS bf16_t* SL; int row0s;
    __device__ __forceinline__ void operator()(const f32x4 (&acc)[2][2][4][2], const Unit& u, int wr, int wc, int fr, int fq) const {
        { const int l_ = lane_id_asm(); fr = l_ & 15; fq = l_ >> 4; }
        const int row0 = u.pm * BM + wr * 64 + fr, col0 = u.pn * BM + wc * 32 + 8 * fq;
        if (u.ks >= 0) {
            PG8_GAS bf16_t* base = SL + ((size_t)u.ks * 1024 + (row0 - row0s)) * 2048 + col0;
#pragma unroll
            for (int ai = 0; ai < 2; ++ai)
#pragma unroll
                for (int m = 0; m < 4; ++m)
#pragma unroll
                    for (int bj = 0; bj < 2; ++bj) { const f32x4 v0 = acc[ai][bj][m][0], v1 = acc[ai][bj][m][1];
                        u32x4 w; w.x = cvt_pk_bf16(v0[0], v0[1]); w.y = cvt_pk_bf16(v0[2], v0[3]); w.z = cvt_pk_bf16(v1[0], v1[1]); w.w = cvt_pk_bf16(v1[2], v1[3]);
                        *(PG8_GAS u32x4*)(base + (size_t)(ai * HALF + m * 16) * 2048 + bj * HALF) = w; }
            return;
        }
#pragma unroll
        for (int ai = 0; ai < 2; ++ai) {
            u32x4 gw[4][2], zo[4][2];
#pragma unroll
            for (int m = 0; m < 4; ++m) { const int row = row0 + ai * HALF + m * 16;
#pragma unroll
                for (int bj = 0; bj < 2; ++bj) { gw[m][bj] = *(const PG8_GAS u32x4*)(Pg + (size_t)row * ldp + col0 + bj * HALF);
                    zo[m][bj] = add ? *(const PG8_GAS u32x4*)(Z + (size_t)row * 2048 + col0 + bj * HALF) : (u32x4){0u, 0u, 0u, 0u}; } }
#pragma unroll
            for (int m = 0; m < 4; ++m) { const int row = row0 + ai * HALF + m * 16;
#pragma unroll
                for (int bj = 0; bj < 2; ++bj) { const u32x4 g = gw[m][bj], z = zo[m][bj];
                    f32x4 v0 = acc[ai][bj][m][0], v1 = acc[ai][bj][m][1];
                    v0[0] = v0[0] * sigmoidf_(bf_lo(g.x)) + bf_lo(z.x); v0[1] = v0[1] * sigmoidf_(bf_hi(g.x)) + bf_hi(z.x); v0[2] = v0[2] * sigmoidf_(bf_lo(g.y)) + bf_lo(z.y); v0[3] = v0[3] * sigmoidf_(bf_hi(g.y)) + bf_hi(z.y);
                    v1[0] = v1[0] * sigmoidf_(bf_lo(g.z)) + bf_lo(z.z); v1[1] = v1[1] * sigmoidf_(bf_hi(g.z)) + bf_hi(z.z); v1[2] = v1[2] * sigmoidf_(bf_lo(g.w)) + bf_lo(z.w); v1[3] = v1[3] * sigmoidf_(bf_hi(g.w)) + bf_hi(z.w);
                    u32x4 w; w.x = cvt_pk_bf16(v0[0], v0[1]); w.y = cvt_pk_bf16(v0[2], v0[3]); w.z = cvt_pk_bf16(v1[0], v1[1]); w.w = cvt_pk_bf16(v1[2], v1[3]);
                    *(PG8_GAS u32x4*)(Z + (size_t)row * 2048 + col0 + bj * HALF) = w; } }
            asm volatile("" ::: "memory"); }
    }
};

template <class Epi, class Sched, bool ALIGN_EPI = false, bool SP2 = false>
__device__ __forceinline__ void gemm_phase(PG8_LAS unsigned char* lds, const Gemm g, const Sched& S, const Epi& E, int wid_in) {
    const int lane_ = lane_id_asm();
    const int wid = __builtin_amdgcn_readfirstlane(wid_in), lane = lane_, tid = wid * 64 + lane, wr = wid >> 2, wc = wid & 3, fr = lane & 15, fq = lane >> 4;
    const int K = g.K;
    unsigned voffA[2], voffB[2];
#pragma unroll
    for (int i = 0; i < 2; ++i) { int R, C; stage_rc(tid * 16 + i * 8192, R, C); const int Rb = Epi::PERM ? ((R & ~31) + perm32(R & 31)) : R;
        voffA[i] = (unsigned)(R * K + C) * 2u; voffB[i] = (unsigned)(Rb * K + C) * 2u; }
    const size_t kstep = (size_t)(BK * 2);
    const size_t hstep = (size_t)HALF * K * 2;
    const size_t tstep = 2 * hstep;
    const unsigned ldsw = (unsigned)wid * 1024u;
    const int aoff = lds_byte(wr * 64 + fr, fq * 8), boff = lds_byte(wc * 32 + fr, fq * 8);
#define PG8_SA(b, h) (((b) * 2 + (h)) * HTB)
#define PG8_SB(b, h) ((4 + (b) * 2 + (h)) * HTB)
#define PG8_STAGE(bufoff, gbase, voff) do { _Pragma("unroll") for (int _i = 0; _i < 2; ++_i) \
        __builtin_amdgcn_global_load_lds((const unsigned*)((const char*)(gbase) + (voff)[_i]), (PG8_LAS unsigned*)(lds + (bufoff) + ldsw + _i * 8192), 16, 0, 0); } while (0)
#define PG8_LDA(dst, b, h) do { _Pragma("unroll") for (int m = 0; m < 4; ++m) _Pragma("unroll") for (int k = 0; k < 2; ++k) dst[m][k] = *(const PG8_LAS bf16x8*)(lds + PG8_SA(b, h) + aoff + m * 2048 + k * 1024); } while (0)
#define PG8_LDB(dst, b, h) do { _Pragma("unroll") for (int n = 0; n < 2; ++n) _Pragma("unroll") for (int k = 0; k < 2; ++k) dst[n][k] = *(const PG8_LAS bf16x8*)(lds + PG8_SB(b, h) + boff + n * 2048 + k * 1024); } while (0)
#define PG8_MMA(ai, bj, At, Bt) do { __builtin_amdgcn_s_setprio(1); _Pragma("unroll") for (int m = 0; m < 4; ++m) _Pragma("unroll") for (int n = 0; n < 2; ++n) _Pragma("unroll") for (int k = 0; k < 2; ++k) \
        acc[ai][bj][m][n] = __builtin_amdgcn_mfma_f32_16x16x32_bf16(Bt[n][k], At[m][k], acc[ai][bj][m][n], 0, 0, 0); __builtin_amdgcn_s_setprio(0); } while (0)
#define PG8_WAIT_V(n) asm volatile("s_waitcnt vmcnt(" #n ")" ::: "memory")
#define PG8_WAIT_L(n) asm volatile("s_waitcnt lgkmcnt(" #n ")" ::: "memory")
#define PG8_BAR __builtin_amdgcn_s_barrier()
#define PG8_SCHED __builtin_amdgcn_sched_barrier(0)
    Unit cur, nxt; int ui = 0;
    if (!S.next(0, cur)) return;
    f32x4 acc[2][2][4][2];
#pragma unroll
    for (int a = 0; a < 2; ++a)
#pragma unroll
        for (int b = 0; b < 2; ++b)
#pragma unroll
            for (int m = 0; m < 4; ++m)
#pragma unroll
                for (int n = 0; n < 2; ++n) acc[a][b][m][n] = (f32x4){0.f, 0.f, 0.f, 0.f};
    bf16x8 At[4][2], B0[2][2], B1[2][2];
    const char* cA = (const char*)g.A + (size_t)cur.pm * tstep + (size_t)cur.kt0 * kstep; const char* cB = (const char*)g.Bt + (size_t)cur.pn * tstep + (size_t)cur.kt0 * kstep;
    S.a_ready(cur);
    if constexpr (SP2) {
        PG8_STAGE(PG8_SB(0, 0), cB, voffB); PG8_STAGE(PG8_SB(0, 1), cB + hstep, voffB); PG8_STAGE(PG8_SA(0, 0), cA, voffA); PG8_STAGE(PG8_SA(0, 1), cA + hstep, voffA);
        if (wr == 1) PG8_BAR;
        PG8_WAIT_V(2); PG8_BAR;
        PG8_STAGE(PG8_SB(1, 0), cB + kstep, voffB); PG8_STAGE(PG8_SA(1, 0), cA + kstep, voffA); PG8_STAGE(PG8_SB(1, 1), cB + hstep + kstep, voffB);
        PG8_WAIT_V(6); PG8_BAR;
    } else {
        PG8_STAGE(PG8_SB(0, 0), cB, voffB); PG8_STAGE(PG8_SA(0, 0), cA, voffA); PG8_STAGE(PG8_SB(0, 1), cB + hstep, voffB); PG8_STAGE(PG8_SA(0, 1), cA + hstep, voffA);
        if (wr == 1) PG8_BAR;
        PG8_WAIT_V(4); PG8_BAR;
        PG8_STAGE(PG8_SB(1, 0), cB + kstep, voffB); PG8_STAGE(PG8_SA(1, 0), cA + kstep, voffA); PG8_STAGE(PG8_SB(1, 1), cB + hstep + kstep, voffB);
        PG8_WAIT_V(6); PG8_BAR;
    }
    for (;;) {
        const bool has_next = S.next(ui + 1, nxt);
        const char* nA = has_next ? (const char*)g.A + (size_t)nxt.pm * tstep + (size_t)nxt.kt0 * kstep : cA; const char* nB = has_next ? (const char*)g.Bt + (size_t)nxt.pn * tstep + (size_t)nxt.kt0 * kstep : cB;
        const int nt = cur.nkt;
        for (int t = 0; t < nt; t += 2) {
            const bool last = (t == nt - 2);
            const char* a1 = cA + (size_t)(t + 1) * kstep;
            const char* a2 = last ? nA : cA + (size_t)(t + 2) * kstep; const char* b2 = last ? nB : cB + (size_t)(t + 2) * kstep;
            const char* a3 = a2 + kstep; const char* b3 = b2 + kstep;
            if (last && has_next) S.a_ready(nxt);
            if constexpr (SP2) {
            PG8_LDB(B0, 0, 0); PG8_LDB(B1, 0, 1); PG8_SCHED; PG8_LDA(At, 0, 0); PG8_STAGE(PG8_SA(1, 1), a1 + hstep, voffA);
            PG8_WAIT_V(8); PG8_WAIT_L(0); PG8_BAR; PG8_MMA(0, 0, At, B0); PG8_MMA(0, 1, At, B1); PG8_BAR; PG8_SCHED;
            PG8_LDA(At, 0, 1); PG8_STAGE(PG8_SB(0, 0), b2, voffB); PG8_STAGE(PG8_SB(0, 1), b2 + hstep, voffB); PG8_STAGE(PG8_SA(0, 0), a2, voffA);
            PG8_WAIT_V(8); PG8_WAIT_L(0); PG8_BAR; PG8_MMA(1, 0, At, B0); PG8_MMA(1, 1, At, B1); PG8_BAR; PG8_SCHED;
            PG8_LDB(B0, 1, 0); PG8_LDB(B1, 1, 1); PG8_SCHED; PG8_LDA(At, 1, 0); PG8_STAGE(PG8_SA(0, 1), a2 + hstep, voffA);
            PG8_WAIT_V(8); PG8_WAIT_L(0); PG8_BAR; PG8_MMA(0, 0, At, B0); PG8_MMA(0, 1, At, B1); PG8_BAR; PG8_SCHED;
            PG8_LDA(At, 1, 1); PG8_STAGE(PG8_SB(1, 0), b3, voffB); PG8_STAGE(PG8_SB(1, 1), b3 + hstep, voffB); PG8_STAGE(PG8_SA(1, 0), a3, voffA);
            PG8_WAIT_V(8); PG8_WAIT_L(0); PG8_BAR; PG8_MMA(1, 0, At, B0); PG8_MMA(1, 1, At, B1); PG8_BAR; PG8_SCHED;
            } else {
            PG8_LDB(B0, 0, 0); PG8_SCHED; PG8_LDA(At, 0, 0); PG8_STAGE(PG8_SA(1, 1), a1 + hstep, voffA);
            PG8_WAIT_L(8); PG8_BAR; PG8_WAIT_L(0); PG8_MMA(0, 0, At, B0); PG8_BAR; PG8_SCHED;
            PG8_LDB(B1, 0, 1); PG8_STAGE(PG8_SB(0, 0), b2, voffB);
            PG8_BAR; PG8_WAIT_L(0); PG8_MMA(0, 1, At, B1); PG8_BAR;
            PG8_LDA(At, 0, 1); PG8_STAGE(PG8_SA(0, 0), a2, voffA);
            PG8_BAR; PG8_WAIT_L(0); PG8_MMA(1, 0, At, B0); PG8_BAR; PG8_SCHED;
            PG8_STAGE(PG8_SB(0, 1), b2 + hstep, voffB);
            PG8_WAIT_V(6); PG8_BAR; PG8_MMA(1, 1, At, B1); PG8_BAR;
            PG8_LDB(B0, 1, 0); PG8_SCHED; PG8_LDA(At, 1, 0); PG8_STAGE(PG8_SA(0, 1), a2 + hstep, voffA);
            PG8_WAIT_L(8); PG8_BAR; PG8_WAIT_L(0); PG8_MMA(0, 0, At, B0); PG8_BAR; PG8_SCHED;
            PG8_LDB(B1, 1, 1); PG8_STAGE(PG8_SB(1, 0), b3, voffB);
            PG8_BAR; PG8_WAIT_L(0); PG8_MMA(0, 1, At, B1); PG8_BAR;
            PG8_LDA(At, 1, 1); PG8_STAGE(PG8_SA(1, 0), a3, voffA);
            PG8_BAR; PG8_WAIT_L(0); PG8_MMA(1, 0, At, B0); PG8_BAR; PG8_SCHED;
            PG8_STAGE(PG8_SB(1, 1), b3 + hstep, voffB);
            PG8_WAIT_V(6); PG8_BAR; PG8_MMA(1, 1, At, B1); PG8_BAR;
            }
        }
        if constexpr (ALIGN_EPI) { if (wr == 0) PG8_BAR; }
        E(acc, cur, wr, wc, fr, fq); S.done(cur);
        if (!has_next) break;
#pragma unroll
        for (int a = 0; a < 2; ++a)
#pragma unroll
            for (int b = 0; b < 2; ++b)
#pragma unroll
                for (int m = 0; m < 4; ++m)
#pragma unroll
                    for (int n = 0; n < 2; ++n) acc[a][b][m][n] = (f32x4){0.f, 0.f, 0.f, 0.f};
        cur = nxt; cA = nA; cB = nB; ++ui;
        if constexpr (ALIGN_EPI) { if (wr == 1) PG8_BAR; }
    }
    PG8_WAIT_V(0);
    if constexpr (!ALIGN_EPI) { if (wr == 0) PG8_BAR; }
    PG8_BAR;
#undef PG8_SA
#undef PG8_SB
#undef PG8_STAGE
#undef PG8_LDA
#undef PG8_LDB
#undef PG8_MMA
#undef PG8_WAIT_V
#undef PG8_WAIT_L
#undef PG8_BAR
#undef PG8_SCHED
}
}

constexpr int NWAVES = 8;
constexpr int D = 2048, DC = 1024, NH = 16, HD = 64, DIN = 10496, DFF = 8192, NL = 4;
constexpr int TP = 4096, TS = 64, BP = 4, BS = 16;
constexpr int MP = BP * TP, MS = BS * TS, M = MP + MS, MA = M + 256;
constexpr int OFF_CB = 1024, OFF_CC = 2048, OFF_R = 3072, OFF_GC = 6400, OFF_GR = 8448, DSHIFT = 3328;
constexpr float RMS_EPS = 1e-6f, GN_EPS = 64e-5f;
constexpr size_t O_YP = 0, O_YS = (size_t)MP * D, O_CONVP = O_YS + (size_t)MS * D, O_SHIFTP = O_CONVP + (size_t)NL * BP * 2 * DC, O_WKVP = O_SHIFTP + (size_t)NL * BP * D,
                 O_CONVS = O_WKVP + (size_t)NL * BP * NH * HD * HD, O_SHIFTS = O_CONVS + (size_t)NL * BS * 2 * DC, O_WKVS = O_SHIFTS + (size_t)NL * BS * D, O_END = O_WKVS + (size_t)NL * BS * NH * HD * HD;
constexpr size_t MiB = 1u << 20;
constexpr size_t WS_CTL = 0, CTL_ZERO_BYTES = 1 * MiB;
constexpr size_t SZ_WIN = (size_t)DIN * D * 2, SZ_WOC = (size_t)D * DC * 2, SZ_WO = (size_t)D * D * 2, SZ_WUP = (size_t)DFF * D * 2, SZ_WLORA = (size_t)3072 * 256 * 2;
constexpr size_t WS_WIN = 1 * MiB, WS_WOC = WS_WIN + NL * SZ_WIN, WS_WOR = WS_WOC + NL * SZ_WOC, WS_WO = WS_WOR + NL * SZ_WOC, WS_WUP = WS_WO + NL * SZ_WO, WS_WDN = WS_WUP + NL * SZ_WUP,
                 WS_WLORA = WS_WDN + NL * SZ_WUP;
constexpr size_t WS_HB = WS_WLORA + NL * SZ_WLORA;
constexpr size_t WS_PU = WS_HB + (size_t)MA * D * 2;
constexpr size_t WS_ACONV = WS_PU + (size_t)MA * DIN * 2;
constexpr size_t WS_ARWKV = WS_ACONV + (size_t)M * DC * 2;
constexpr size_t WS_RKV = WS_ARWKV + (size_t)M * DC * 2;
constexpr size_t WS_WD = WS_RKV + (size_t)M * 3072 * 2;
constexpr size_t WS_AA = WS_WD + (size_t)M * DC * 4;
constexpr size_t WS_GG = WS_AA + (size_t)M * DC * 4;
constexpr size_t WS_LL = WS_GG + (size_t)M * DC * 2;
constexpr size_t WS_END = WS_LL + (size_t)M * 256 * 2;
static_assert(WS_END <= 1375731712ull, "workspace map exceeds 4 x largest tensor");
static_assert((size_t)M * DFF * 2 <= (size_t)MA * DIN * 2 && (size_t)M * D * 2 <= (size_t)M * 3072 * 2, "overlays");
constexpr int CW_BAR = 4096;

constexpr int RING_OFF = 0, RING_BYTES = 131072;
constexpr int LDSCTL_OFF = RING_BYTES, MISC_OFF = LDSCTL_OFF + 320;
constexpr int LDS_BYTES = 147456;

#define GAS __attribute__((address_space(1)))
#define LAS __attribute__((address_space(3)))
typedef unsigned short bf16;
typedef unsigned v4u __attribute__((ext_vector_type(4)));
typedef unsigned v2u __attribute__((ext_vector_type(2)));
typedef float f32x4 __attribute__((ext_vector_type(4)));
typedef GAS unsigned gu32;
#define RLX_AGENT __ATOMIC_RELAXED, __HIP_MEMORY_SCOPE_AGENT
#define LDS_WAIT() asm volatile("s_waitcnt lgkmcnt(0)" ::: "memory")
#define VM_WAIT() asm volatile("s_waitcnt vmcnt(0)" ::: "memory")
__device__ __forceinline__ unsigned pk2(float lo, float hi) { return pg8::cvt_pk_bf16(lo, hi); }
__device__ __forceinline__ unsigned f2bf(float f) { return pk2(f, f) & 0xffffu; }
using pg8::bf_lo; using pg8::bf_hi; using pg8::sigmoidf_;

#define XB_TMO      128
#define XB_XCNT(j)  (256  + 64 * (j))
#define XB_XSUB(j)  (1280 + 64 * (j))
#define XB_XGEN(j)  (2304 + 64 * (j))
#define XB_TOP      3328
#define XB_TOPGEN   3392
#define XCD_BAR_WORDS 3456
#define XB_SPIN_CAP (1u << 18)
__device__ __forceinline__ unsigned xb_ld(unsigned* p)              { return __hip_atomic_load(p, __ATOMIC_RELAXED, __HIP_MEMORY_SCOPE_AGENT); }
__device__ __forceinline__ unsigned xb_add(unsigned* p, unsigned v) { return __hip_atomic_fetch_add(p, v, __ATOMIC_RELAXED, __HIP_MEMORY_SCOPE_AGENT); }
__device__ __forceinline__ unsigned xb_xcc_id() { return (unsigned)__builtin_amdgcn_s_getreg((3 << 11) | 20) & 0xFu; }
#define XB_SPIN(cond, bar) do { unsigned _sp = 0; while (cond) { __builtin_amdgcn_s_sleep(1); \
    if ((++_sp & 255u) == 0u) { if (xb_ld(&(bar)[XB_TMO])) break; if (_sp > XB_SPIN_CAP) { atomicAdd(&(bar)[XB_TMO], 1u); break; } } } } while (0)
struct XcdBarrier { unsigned* bar; unsigned x; volatile LAS unsigned* st; int wave; };
__device__ __forceinline__ bool xb_t0(int wave) { return wave == 0 && lane_id_asm() == 0; }
__device__ __forceinline__ XcdBarrier xcd_barrier_post(unsigned* bar, volatile LAS unsigned* st, int wave) {
    XcdBarrier b; b.bar = bar; b.x = xb_xcc_id(); b.st = st; b.wave = wave;
    if (xb_t0(wave)) (void)xb_add(&bar[XB_XCNT(b.x)], 1u);
    return b;
}
__device__ __forceinline__ void xcd_barrier_complete(unsigned* bar, unsigned x, unsigned& nloc, unsigned& nx) {
    const unsigned G = gridDim.x * gridDim.y * gridDim.z;
    unsigned sum, cnt, mine, sp = 0u;
    for (;;) {
        sum = 0u; cnt = 0u; mine = 0u;
#pragma unroll
        for (unsigned j = 0; j < 16; ++j) { const unsigned c = xb_ld(&bar[XB_XCNT(j)]); sum += c; cnt += (c > 0u) ? 1u : 0u; mine = (j == x) ? c : mine; }
        if (sum == G) break;
        __builtin_amdgcn_s_sleep(1);
        if ((++sp & 255u) == 0u) { if (xb_ld(&bar[XB_TMO])) break; if (sp > XB_SPIN_CAP) { atomicAdd(&bar[XB_TMO], 1u); break; } }
    }
    nloc = mine > 0u ? mine : 1u; nx = cnt > 0u ? cnt : 1u;
}
__device__ __forceinline__ void xcd_barrier(const XcdBarrier& b) {
    asm volatile("s_waitcnt vmcnt(0)" ::: "memory");
    __syncthreads();
    if (xb_t0(b.wave)) {
        unsigned* bar = b.bar; unsigned bx = b.x;
        asm volatile("" : "+s"(bar), "+s"(bx));
        __builtin_amdgcn_s_waitcnt(0);
        unsigned nloc = b.st[0], nx = b.st[1];
        if (nloc == 0u) { xcd_barrier_complete(bar, bx, nloc, nx); b.st[0] = nloc; b.st[1] = nx; }
        const unsigned old = xb_add(&bar[XB_XSUB(bx)], 1u);
        const unsigned gen = old / nloc;
        if (old + 1u == (gen + 1u) * nloc) {
            __builtin_amdgcn_fence(__ATOMIC_RELEASE, "agent");
            asm volatile("s_waitcnt vmcnt(0)" ::: "memory");
            const unsigned og = xb_add(&bar[XB_TOP], 1u);
            const unsigned tg = og / nx;
            if (og + 1u == (tg + 1u) * nx) xb_add(&bar[XB_TOPGEN], 1u);
            else XB_SPIN(xb_ld(&bar[XB_TOPGEN]) == tg, bar);
            __builtin_amdgcn_fence(__ATOMIC_ACQUIRE, "agent");
            asm volatile("s_waitcnt vmcnt(0)" ::: "memory");
        } else {
            XB_SPIN(xb_ld(&bar[XB_TOPGEN]) == gen, bar);
            __builtin_amdgcn_fence(__ATOMIC_ACQUIRE, "agent");
            asm volatile("s_waitcnt vmcnt(0)" ::: "memory");
        }
    }
    __syncthreads();
}

struct Args { const float* in[26]; float* out; unsigned char* ws; int st_lo, st_hi; };
struct Frame {
    LAS unsigned char* lds;
    int wave, vcu, G;
    float* out; unsigned char* ws;
};
typedef const unsigned char __attribute__((address_space(4)))* kptr_t;
__device__ __forceinline__ kptr_t kargs() { kptr_t p = (kptr_t)__builtin_amdgcn_kernarg_segment_ptr(); asm volatile("" : "+s"(p)); return p; }
#define INP(k) (*(const float* const __attribute__((address_space(4)))*)(ka + 8 * (k)))
template <class T> __device__ __forceinline__ T* launder_s(T* p) { asm volatile("" : "+s"(p)); return p; }
template <class T> __device__ __forceinline__ LAS T* launder_l(LAS T* p) { asm volatile("" : "+v"(p)); return p; }
__device__ __forceinline__ int launder_si(int v) { asm volatile("" : "+s"(v)); return v; }
__device__ __forceinline__ int launder_v(int v) { asm volatile("" : "+v"(v)); return v; }
__device__ __forceinline__ void lds_barrier() { asm volatile("s_waitcnt lgkmcnt(0)" ::: "memory"); __builtin_amdgcn_s_barrier(); asm volatile("" ::: "memory"); }
__device__ __forceinline__ unsigned ldg_u16(const GAS void* sbase, unsigned voff) { return *(const GAS unsigned short*)((const GAS char*)sbase + voff); }
__device__ __forceinline__ float ldg_f32(const GAS void* sbase, unsigned voff) { return *(const GAS float*)((const GAS char*)sbase + voff); }
__device__ __forceinline__ v4u ldg_v4(const GAS void* sbase, unsigned voff) { return *(const GAS v4u*)((const GAS char*)sbase + voff); }
__device__ __forceinline__ void stg_v2(GAS void* sbase, unsigned voff, v2u v) { *(GAS v2u*)((GAS char*)sbase + voff) = v; }
__device__ __forceinline__ void stg_v4(GAS void* sbase, unsigned voff, v4u v) { *(GAS v4u*)((GAS char*)sbase + voff) = v; }
template <int CTRL> __device__ __forceinline__ float dppf(float v) { return __builtin_bit_cast(float, __builtin_amdgcn_mov_dpp(__builtin_bit_cast(int, v), CTRL, 0xf, 0xf, true)); }
__device__ __forceinline__ float wave_sum(float v) {
    v += dppf<0xB1>(v); v += dppf<0x4E>(v); v += dppf<0x141>(v); v += dppf<0x140>(v);
    return (__builtin_bit_cast(float, __builtin_amdgcn_readlane(__builtin_bit_cast(int, v), 0)) + __builtin_bit_cast(float, __builtin_amdgcn_readlane(__builtin_bit_cast(int, v), 16))) +
           (__builtin_bit_cast(float, __builtin_amdgcn_readlane(__builtin_bit_cast(int, v), 32)) + __builtin_bit_cast(float, __builtin_amdgcn_readlane(__builtin_bit_cast(int, v), 48)));
}
__device__ __forceinline__ float sum8(float v) { v += dppf<0xB1>(v); v += dppf<0x4E>(v); v += dppf<0x141>(v); return v; }

__device__ __forceinline__ void p0_transpose_item(const float* W, int K, int N, bf16* WT, LAS float* scr, int item, int lane) {
    const int nblk = N / 32, kb = item / nblk, nb = item % nblk, k0 = 64 * kb, n0 = 32 * nb;
#pragma unroll 8
    for (int i = 0; i < 32; ++i) { const int kk = 2 * i + (lane >> 5); scr[kk * 33 + (lane & 31)] = ((const GAS float*)W)[(size_t)(k0 + kk) * N + n0 + (lane & 31)]; }
    LDS_WAIT(); asm volatile("" ::: "memory");
    const int c = lane & 7;
#pragma unroll
    for (int j = 0; j < 4; ++j) { const int n = (lane >> 3) + 8 * j; const LAS float* s = scr + (8 * c) * 33 + n;
        v4u o; o.x = pk2(s[0 * 33], s[1 * 33]); o.y = pk2(s[2 * 33], s[3 * 33]); o.z = pk2(s[4 * 33], s[5 * 33]); o.w = pk2(s[6 * 33], s[7 * 33]);
        *(GAS v4u*)(WT + (size_t)(n0 + n) * K + k0 + 8 * c) = o; }
    LDS_WAIT(); asm volatile("" ::: "memory");
}

__device__ __forceinline__ void phase_prologue(Frame& F) {
    const kptr_t ka = kargs(); const int lane = lane_id_asm(), tid = F.wave * 64 + lane; (void)tid; (void)ka;
    unsigned char* const ws_ = launder_s(F.ws); float* const out_ = launder_s(F.out); (void)ws_; (void)out_;
    LAS float* scr = (LAS float*)(F.lds + RING_OFF + F.wave * 16384);
    const int gw = launder_si(F.vcu * NWAVES + F.wave), NGW = F.G * NWAVES;
    constexpr int I_IN = (D / 64) * (DIN / 32), I_OC = (DC / 64) * (D / 32), I_O = (D / 64) * (D / 32), I_UP = (D / 64) * (DFF / 32), I_DN = (DFF / 64) * (D / 32);
    constexpr int PER_L = I_IN + 2 * I_OC + I_O + I_UP + I_DN, NITEMS = NL * PER_L;
    for (int it = gw; it < NITEMS; it += NGW) {
        const int l = it / PER_L; int r = it % PER_L;
        if (r < I_IN) { p0_transpose_item(INP(6) + (size_t)l * D * DIN, D, DIN, (bf16*)(ws_ + WS_WIN + l * SZ_WIN), scr, r, lane); continue; } r -= I_IN;
        if (r < I_OC) { p0_transpose_item(INP(19) + (size_t)l * DC * D, DC, D, (bf16*)(ws_ + WS_WOC + l * SZ_WOC), scr, r, lane); continue; } r -= I_OC;
        if (r < I_OC) { p0_transpose_item(INP(20) + (size_t)l * DC * D, DC, D, (bf16*)(ws_ + WS_WOR + l * SZ_WOC), scr, r, lane); continue; } r -= I_OC;
        if (r < I_O) { p0_transpose_item(INP(21) + (size_t)l * D * D, D, D, (bf16*)(ws_ + WS_WO + l * SZ_WO), scr, r, lane); continue; } r -= I_O;
        if (r < I_UP) { p0_transpose_item(INP(23) + (size_t)l * D * DFF, D, DFF, (bf16*)(ws_ + WS_WUP + l * SZ_WUP), scr, r, lane); continue; } r -= I_UP;
        p0_transpose_item(INP(24) + (size_t)l * DFF * D, DFF, D, (bf16*)(ws_ + WS_WDN + l * SZ_WUP), scr, r, lane);
    }
    const int gt = (F.vcu * NWAVES + F.wave) * 64 + lane, NGT = NGW * 64;
    for (int it = gt; it < NL * 3072 * 32; it += NGT) {
        const int l = it / (3072 * 32), rr = it % (3072 * 32), n = rr >> 5, k0 = (rr & 31) * 8;
        float v[8];
#pragma unroll
        for (int j = 0; j < 8; ++j) { const int k = k0 + j; float x = 0.f;
            if (n < 1024) { if (k < 64) x = ((const GAS float*)INP(10))[((size_t)l * 64 + k) * 1024 + n]; }
            else if (n < 2048) { if (k >= 64 && k < 128) x = ((const GAS float*)INP(12))[((size_t)l * 64 + (k - 64)) * 1024 + (n - 1024)]; }
            else { if (k >= 128) x = ((const GAS float*)INP(13))[((size_t)l * 128 + (k - 128)) * 1024 + (n - 2048)]; }
            v[j] = x; }
        v4u o; o.x = pk2(v[0], v[1]); o.y = pk2(v[2], v[3]); o.z = pk2(v[4], v[5]); o.w = pk2(v[6], v[7]);
        *(GAS v4u*)((bf16*)(ws_ + WS_WLORA + l * SZ_WLORA) + (size_t)n * 256 + k0) = o;
    }
}

__device__ __forceinline__ void unpack8(const v4u w, float (&f)[8]) { f[0] = bf_lo(w.x); f[1] = bf_hi(w.x); f[2] = bf_lo(w.y); f[3] = bf_hi(w.y); f[4] = bf_lo(w.z); f[5] = bf_hi(w.z); f[6] = bf_lo(w.w); f[7] = bf_hi(w.w); }
__device__ __forceinline__ v4u pack8(const float (&f)[8]) { v4u o; o.x = pk2(f[0], f[1]); o.y = pk2(f[2], f[3]); o.z = pk2(f[4], f[5]); o.w = pk2(f[6], f[7]); return o; }
__device__ __forceinline__ void phase_norm(Frame& F, int l, int mode) {
    const kptr_t ka = kargs(); const int lane = lane_id_asm(), tid = F.wave * 64 + lane; (void)tid; (void)ka;
    unsigned char* const ws_ = launder_s(F.ws); float* const out_ = launder_s(F.out); (void)ws_; (void)out_;
    const int gw = launder_si(F.vcu * NWAVES + F.wave), NGW = F.G * NWAVES;
    GAS bf16* XB = (GAS bf16*)out_; GAS bf16* XS = (GAS bf16*)(ws_ + WS_RKV); GAS bf16* HB = (GAS bf16*)(ws_ + WS_HB);
    const float* gain = (mode == 0) ? INP(5) + (size_t)l * D : (mode == 1) ? INP(22) + (size_t)l * D : INP(25);
    if (mode == 0 && gw < BS) {
        const int j = gw; GAS v2u* o8 = (GAS v2u*)(HB + (size_t)(M + j) * D) + lane;
#pragma unroll
        for (int q = 0; q < 8; ++q) { const f32x4 s = *((const GAS f32x4*)(INP(3) + ((size_t)l * BS + j) * D) + lane + 64 * q); v2u w; w.x = pk2(s.x, s.y); w.y = pk2(s.z, s.w); o8[64 * q] = w; }
    }
    f32x4 g[4][2];
#pragma unroll
    for (int q = 0; q < 4; ++q) { const GAS f32x4* gp = (const GAS f32x4*)(gain + q * 512 + lane * 8); g[q][0] = gp[0]; g[q][1] = gp[1]; }
    const bool from_in = (mode == 0 && l == 0);
    const GAS bf16* XR = (mode == 2) ? XS : XB;
    GAS bf16* XW = (mode == 1 && l == NL - 1) ? XS : XB;
    f32x4 nf[4][2]; v4u nb[4];
#define NORM_LOAD(mm) do { if (from_in) { const float* src_ = ((mm) < MP) ? INP(0) + (size_t)(mm) * D : INP(1) + (size_t)((mm) - MP) * D; \
            _Pragma("unroll") for (int q = 0; q < 4; ++q) { const GAS f32x4* p_ = (const GAS f32x4*)(src_ + q * 512 + lane * 8); nf[q][0] = p_[0]; nf[q][1] = p_[1]; } } \
        else { _Pragma("unroll") for (int q = 0; q < 4; ++q) nb[q] = *(const GAS v4u*)(XR + (size_t)(mm) * D + q * 512 + lane * 8); } } while (0)
    if (gw < M) NORM_LOAD(gw);
    for (int m = gw; m < M; m += NGW) {
        float v[4][8];
        if (from_in) {
#pragma unroll
            for (int q = 0; q < 4; ++q) { v[q][0] = nf[q][0].x; v[q][1] = nf[q][0].y; v[q][2] = nf[q][0].z; v[q][3] = nf[q][0].w; v[q][4] = nf[q][1].x; v[q][5] = nf[q][1].y; v[q][6] = nf[q][1].z; v[q][7] = nf[q][1].w; } }
        else {
#pragma unroll
            for (int q = 0; q < 4; ++q) unpack8(nb[q], v[q]); }
        if (m + NGW < M) NORM_LOAD(m + NGW);
        const bool slab = (m >= MP) && !from_in;
        if (slab) { const GAS bf16* SL = (const GAS bf16*)(ws_ + WS_WD) + (size_t)(m - MP) * D;
#pragma unroll
            for (int hq = 0; hq < 2; ++hq) {
                v4u sv[2][8];
#pragma unroll
                for (int q = 0; q < 2; ++q)
#pragma unroll
                    for (int k8 = 0; k8 < 8; ++k8) sv[q][k8] = *(const GAS v4u*)(SL + (size_t)k8 * MS * D + (2 * hq + q) * 512 + lane * 8);
#pragma unroll
                for (int q = 0; q < 2; ++q)
#pragma unroll
                    for (int k8 = 0; k8 < 8; ++k8) { float p[8]; unpack8(sv[q][k8], p);
#pragma unroll
                        for (int j = 0; j < 8; ++j) v[2 * hq + q][j] += p[j]; } } }
        if (from_in || (slab && mode != 2)) {
#pragma unroll
            for (int q = 0; q < 4; ++q) { const v4u w = pack8(v[q]); *(GAS v4u*)(XW + (size_t)m * D + q * 512 + lane * 8) = w; unpack8(w, v[q]); } }
        float s = 0.f;
#pragma unroll
        for (int q = 0; q < 4; ++q)
#pragma unroll
            for (int j = 0; j < 8; ++j) s += v[q][j] * v[q][j];
        const float rstd = __builtin_amdgcn_rsqf(wave_sum(s) * (1.f / D) + RMS_EPS);
#pragma unroll
        for (int q = 0; q < 4; ++q) { v[q][0] *= rstd * g[q][0].x; v[q][1] *= rstd * g[q][0].y; v[q][2] *= rstd * g[q][0].z; v[q][3] *= rstd * g[q][0].w; v[q][4] *= rstd * g[q][1].x; v[q][5] *= rstd * g[q][1].y; v[q][6] *= rstd * g[q][1].z; v[q][7] *= rstd * g[q][1].w; }
        if (mode == 2) {
#pragma unroll
            for (int q = 0; q < 4; ++q) { GAS f32x4* o = (GAS f32x4*)(out_ + (size_t)m * D + q * 512 + lane * 8); o[0] = (f32x4){v[q][0], v[q][1], v[q][2], v[q][3]}; o[1] = (f32x4){v[q][4], v[q][5], v[q][6], v[q][7]}; }
            continue; }
#pragma unroll
        for (int q = 0; q < 4; ++q) *(GAS v4u*)(HB + (size_t)m * D + q * 512 + lane * 8) = pack8(v[q]);
        if (mode == 0) {
            float* so = nullptr;
            if (m < MP) { if ((m & (TP - 1)) == TP - 1) so = out_ + O_SHIFTP + ((size_t)l * BP + (m >> 12)) * D; }
            else { const int ms = m - MP; if ((ms & (TS - 1)) == TS - 1) so = out_ + O_SHIFTS + ((size_t)l * BS + (ms >> 6)) * D; }
            if (so) {
#pragma unroll
                for (int q = 0; q < 4; ++q) { GAS f32x4* o = (GAS f32x4*)(so + q * 512 + lane * 8); o[0] = (f32x4){v[q][0], v[q][1], v[q][2], v[q][3]}; o[1] = (f32x4){v[q][4], v[q][5], v[q][6], v[q][7]}; } }
        }
    }
#undef NORM_LOAD
}

__device__ __forceinline__ void phase_mix(Frame& F, int l) {
    const kptr_t ka = kargs(); const int lane = lane_id_asm(), tid = F.wave * 64 + lane; (void)tid; (void)ka;
    unsigned char* const ws_ = launder_s(F.ws); float* const out_ = launder_s(F.out); (void)ws_; (void)out_;
    const int gw = launder_si(F.vcu * NWAVES + F.wave), NGW = F.G * NWAVES;
    const GAS bf16* P = (const GAS bf16*)(ws_ + WS_PU);
    GAS bf16* ACONV = (GAS bf16*)(ws_ + WS_ACONV); GAS bf16* RKV = (GAS bf16*)(ws_ + WS_RKV); GAS bf16* LL = (GAS bf16*)(ws_ + WS_LL);
    const GAS float* mu = (const GAS float*)(INP(7) + (size_t)l * DSHIFT); const GAS float* cw = (const GAS float*)(INP(8) + (size_t)l * 3 * DC);
    constexpr int NITEM = (M / 8) * 5;
    for (int it = gw; it < NITEM; it += NGW) {
        const int tb = it / 5, c5 = it - tb * 5, ch = (c5 < 2) ? c5 : c5 + 4, m0 = tb * 8;
        int b, t0, T; bool samp;
        if (m0 < MP) { b = m0 >> 12; t0 = m0 & (TP - 1); T = TP; samp = false; } else { const int ms = m0 - MP; b = ms >> 6; t0 = ms & (TS - 1); T = TS; samp = true; }
        const GAS bf16* p0 = P + (size_t)m0 * DIN;
        if (ch < 2) {
            const int c = ch * 512 + lane * 8;
            v4u rin[10], rcc[10], rcb[8];
#pragma unroll
            for (int i = 0; i < 10; ++i) if (i >= 2 || t0 > 0) { rin[i] = *(const GAS v4u*)(p0 + (ptrdiff_t)(i - 2) * DIN + c); rcc[i] = *(const GAS v4u*)(p0 + (ptrdiff_t)(i - 2) * DIN + OFF_CC + c); }
#pragma unroll
            for (int i = 0; i < 8; ++i) rcb[i] = *(const GAS v4u*)(p0 + (size_t)i * DIN + OFF_CB + c);
            float w0[8], w1[8], w2[8];
            { const f32x4 a0 = *(const GAS f32x4*)(cw + c), a1 = *(const GAS f32x4*)(cw + c + 4), b0 = *(const GAS f32x4*)(cw + DC + c), b1 = *(const GAS f32x4*)(cw + DC + c + 4), c0 = *(const GAS f32x4*)(cw + 2 * DC + c), c1 = *(const GAS f32x4*)(cw + 2 * DC + c + 4);
              w0[0] = a0.x; w0[1] = a0.y; w0[2] = a0.z; w0[3] = a0.w; w0[4] = a1.x; w0[5] = a1.y; w0[6] = a1.z; w0[7] = a1.w;
              w1[0] = b0.x; w1[1] = b0.y; w1[2] = b0.z; w1[3] = b0.w; w1[4] = b1.x; w1[5] = b1.y; w1[6] = b1.z; w1[7] = b1.w;
              w2[0] = c0.x; w2[1] = c0.y; w2[2] = c0.z; w2[3] = c0.w; w2[4] = c1.x; w2[5] = c1.y; w2[6] = c1.z; w2[7] = c1.w; }
            float um2[8], um1[8];
            if (t0 > 0) { float x[8], y[8]; unpack8(rin[0], x); unpack8(rcc[0], y);
#pragma unroll
                for (int j = 0; j < 8; ++j) um2[j] = x[j] * y[j];
                unpack8(rin[1], x); unpack8(rcc[1], y);
#pragma unroll
                for (int j = 0; j < 8; ++j) um1[j] = x[j] * y[j]; }
            else if (samp) { const GAS float* cst = (const GAS float*)(INP(2) + ((size_t)l * BS + b) * 2 * DC) + c;
#pragma unroll
                for (int j = 0; j < 8; ++j) { um2[j] = cst[j]; um1[j] = cst[DC + j]; } }
            else {
#pragma unroll
                for (int j = 0; j < 8; ++j) { um2[j] = 0.f; um1[j] = 0.f; } }
            GAS float* cout = (GAS float*)out_ + (samp ? O_CONVS + ((size_t)l * BS + b) * 2 * DC : O_CONVP + ((size_t)l * BP + b) * 2 * DC) + c;
            const bool lastb = (t0 + 8 == T);
#pragma unroll
            for (int i = 0; i < 8; ++i) { float x[8], y[8], cb[8], u[8], o[8]; unpack8(rin[i + 2], x); unpack8(rcc[i + 2], y); unpack8(rcb[i], cb);
#pragma unroll
                for (int j = 0; j < 8; ++j) { u[j] = x[j] * y[j]; o[j] = cb[j] * (w0[j] * um2[j] + w1[j] * um1[j] + w2[j] * u[j]); um2[j] = um1[j]; um1[j] = u[j]; }
                *(GAS v4u*)(ACONV + (size_t)(m0 + i) * DC + c) = pack8(o);
                if (lastb && i >= 6) {
#pragma unroll
                    for (int j = 0; j < 8; ++j) cout[(size_t)(i - 6) * DC + j] = u[j]; } }
        } else {
            const int cl = (ch - 2) * 512 + lane * 8;
            if (cl < DSHIFT) {
                v4u rc[9];
                const GAS bf16* pm1 = (t0 > 0) ? p0 - DIN : (samp ? P + (size_t)(M + b) * DIN : nullptr);
                if (pm1) rc[0] = *(const GAS v4u*)(pm1 + OFF_R + cl); else rc[0] = (v4u){0u, 0u, 0u, 0u};
#pragma unroll
                for (int i = 0; i < 8; ++i) rc[i + 1] = *(const GAS v4u*)(p0 + (size_t)i * DIN + OFF_R + cl);
                float muv[8];
                { const f32x4 a0 = *(const GAS f32x4*)(mu + cl), a1 = *(const GAS f32x4*)(mu + cl + 4); muv[0] = a0.x; muv[1] = a0.y; muv[2] = a0.z; muv[3] = a0.w; muv[4] = a1.x; muv[5] = a1.y; muv[6] = a1.z; muv[7] = a1.w; }
                float prv[8]; unpack8(rc[0], prv);
#pragma unroll
                for (int i = 0; i < 8; ++i) { float cur[8], mx[8]; unpack8(rc[i + 1], cur);
#pragma unroll
                    for (int j = 0; j < 8; ++j) { mx[j] = cur[j] + muv[j] * (prv[j] - cur[j]); prv[j] = cur[j]; }
                    if (ch < 8) *(GAS v4u*)(RKV + (size_t)(m0 + i) * 3072 + cl) = pack8(mx);
                    else { const int q = cl - 3072;
                        if (q < 64) {
#pragma unroll
                            for (int j = 0; j < 8; ++j) mx[j] = 1.0f - 2.0f * __builtin_amdgcn_rcpf(1.0f + __expf(2.0f * mx[j]));
                        } else if (q >= 128) {
#pragma unroll
                            for (int j = 0; j < 8; ++j) mx[j] = sigmoidf_(mx[j]);
                        }
                        *(GAS v4u*)(LL + (size_t)(m0 + i) * 256 + q) = pack8(mx); } }
            }
        }
    }
}

__device__ __forceinline__ void phase_zred(Frame& F) {
    const int lane = lane_id_asm();
    unsigned char* const ws_ = launder_s(F.ws);
    const int gw = launder_si(F.vcu * NWAVES + F.wave), NGW = F.G * NWAVES;
    const GAS bf16* P = (const GAS bf16*)(ws_ + WS_PU); GAS bf16* Z = (GAS bf16*)(ws_ + WS_RKV);
    const GAS bf16* SC_ = (const GAS bf16*)(ws_ + WS_WD); const GAS bf16* SR_ = (const GAS bf16*)(ws_ + WS_AA);
    for (int it = gw; it < MS * 4; it += NGW) {
        const int r = it >> 2, q = it & 3; const size_t m = (size_t)MP + r;
        { const int c = q * 512 + lane * 8;
            float gc[8], gr[8], sc[8], sr[8], o[8];
            const v4u gcw = *(const GAS v4u*)(P + m * DIN + OFF_GC + c), grw = *(const GAS v4u*)(P + m * DIN + OFF_GR + c);
            v4u ca[4], cb[4];
#pragma unroll
            for (int k4 = 0; k4 < 4; ++k4) { const size_t off = ((size_t)k4 * MS + r) * D + c; ca[k4] = *(const GAS v4u*)(SC_ + off); cb[k4] = *(const GAS v4u*)(SR_ + off); }
            unpack8(gcw, gc); unpack8(grw, gr);
#pragma unroll
            for (int j = 0; j < 8; ++j) { sc[j] = 0.f; sr[j] = 0.f; }
#pragma unroll
            for (int k4 = 0; k4 < 4; ++k4) { float pa[8], pb[8]; unpack8(ca[k4], pa); unpack8(cb[k4], pb);
#pragma unroll
                for (int j = 0; j < 8; ++j) { sc[j] += pa[j]; sr[j] += pb[j]; } }
#pragma unroll
            for (int j = 0; j < 8; ++j) o[j] = sigmoidf_(gc[j]) * sc[j] + sigmoidf_(gr[j]) * sr[j];
            *(GAS v4u*)(Z + m * D + c) = pack8(o); }
    }
}

constexpr int NCHUNK = BP * NH * (TP / 64) + BS * NH;
constexpr int CP = 72;
constexpr int L_QK = 0, L_RT = 9216, L_KT = 18432, L_BT = 27648, L_VT = 36864, L_KHT = 46080, L_BHT = 55296, L_LB = 64512, L_AKK = 73728, L_ARK = 82944, L_ARB = 92160,
              L_XF = 101376, XP = 68, L_LD = L_XF + 64 * XP * 4, L_WC = L_LD + 4096, L_GT = L_WC + 256, L_TB = L_GT + 2048, TBP = 40, L_END1 = L_TB + 64 * TBP * 2, ATP = 32;
static_assert(L_END1 <= RING_BYTES && 128 * ATP * 2 <= 9216, "scan1 LDS map");
typedef short bf16x8 __attribute__((ext_vector_type(8)));
__device__ __forceinline__ f32x4 mma16(bf16x8 a, bf16x8 b, f32x4 c) { return __builtin_amdgcn_mfma_f32_16x16x32_bf16(a, b, c, 0, 0, 0); }
__device__ __forceinline__ bf16x8 frag(const LAS bf16* base, int blk, int ks, int lane) { return *(const LAS bf16x8*)(base + (16 * blk + (lane & 15)) * CP + 32 * ks + 8 * (lane >> 4)); }
__device__ __forceinline__ v2u pack4(const f32x4 v) { v2u o; o.x = pk2(v[0], v[1]); o.y = pk2(v[2], v[3]); return o; }
__device__ __forceinline__ void chunk_coords(int cidx, int& m0, int& h) {
    if (cidx < BP * NH * 64) { const int b = cidx >> 10; h = (cidx >> 6) & 15; m0 = b * TP + (cidx & 63) * 64; }
    else { const int q = cidx - BP * NH * 64; h = q & 15; m0 = MP + (q >> 4) * TS; }
}

__device__ __forceinline__ void phase_scan1(Frame& F, int l) {
    const kptr_t ka = kargs(); const int lane0 = lane_id_asm(); (void)ka;
    unsigned char* const ws_ = launder_s(F.ws);
    LAS unsigned char* const B0 = F.lds + RING_OFF;
    LAS bf16* QK = launder_l((LAS bf16*)(B0 + L_QK)); LAS bf16* RT = launder_l((LAS bf16*)(B0 + L_RT)); LAS bf16* KT = launder_l((LAS bf16*)(B0 + L_KT)); LAS bf16* BT = KT + 64 * CP;
    LAS bf16* VT = launder_l((LAS bf16*)(B0 + L_VT)); LAS bf16* KHT = launder_l((LAS bf16*)(B0 + L_KHT)); LAS bf16* BHT = launder_l((LAS bf16*)(B0 + L_BHT));
    LAS bf16* LB = launder_l((LAS bf16*)(B0 + L_LB)); LAS bf16* AKK = launder_l((LAS bf16*)(B0 + L_AKK)); LAS bf16* ARK = launder_l((LAS bf16*)(B0 + L_ARK)); LAS bf16* ARB = launder_l((LAS bf16*)(B0 + L_ARB));
    LAS bf16* PT = KT; LAS bf16* U0T = BT;
    LAS float* XF = launder_l((LAS float*)(B0 + L_XF)); LAS float* LD = launder_l((LAS float*)(B0 + L_LD)); LAS float* WC = LD + 1024; LAS float* GT = WC + 64;
    LAS bf16* ACCT = AKK;
    LAS bf16* TBt = (LAS bf16*)(GT + 512);
    GAS bf16* RKV = (GAS bf16*)(ws_ + WS_RKV); const GAS bf16* PJ = (const GAS bf16*)(ws_ + WS_PU); GAS float* WD = (GAS float*)(ws_ + WS_WD); GAS bf16* AA = (GAS bf16*)(ws_ + WS_AA); GAS float* BON = (GAS float*)(ws_ + WS_GG);
    const GAS bf16* LL = (const GAS bf16*)(ws_ + WS_LL); const GAS bf16* WL = (const GAS bf16*)(ws_ + WS_WLORA + (size_t)l * SZ_WLORA);
    LAS float* STW = XF; LAS float* STA = launder_l((LAS float*)(B0 + L_LB));
    LAS float* BIAS = launder_l((LAS float*)(F.lds + LDSCTL_OFF + 1024));
    const GAS float* k_k = (const GAS float*)(INP(14) + (size_t)l * DC); const GAS float* k_a = (const GAS float*)(INP(15) + (size_t)l * DC); const GAS float* r_k = (const GAS float*)(INP(16) + (size_t)l * DC); const GAS float* mu_ = (const GAS float*)(INP(7) + (size_t)l * DSHIFT);
    const int w = F.wave, G = F.G;
    const int tm = w >> 1, tn0 = (w & 1) * 2;
#define STAGE_LANE const int lane = launder_v(lane0), fr = lane & 15, fq = lane >> 4, tid = w * 64 + lane; (void)fr; (void)fq; (void)tid
    { const int lane = launder_v(lane0); for (int i = w * 64 + lane; i < 64 * TBP * 2 / 4; i += NWAVES * 64) ((LAS unsigned*)TBt)[i] = 0u; }
    { const int lane = launder_v(lane0); const int i4 = (w * 64 + lane) * 4; const GAS float* src = (i4 < 1024) ? (const GAS float*)(INP(9) + (size_t)l * DC) + i4 : (const GAS float*)(INP(11) + (size_t)l * DC) + (i4 - 1024);
      *(LAS f32x4*)(BIAS + i4) = *(const GAS f32x4*)src; }
    unsigned rvw[8], kvw[8], vvw[8], rpw, kpw;
    v4u lfa[2], lfw[8];
#define LORA_LOAD(ci) do { const int lane = launder_v(lane0), fr_ = lane & 15, fq_ = lane >> 4; int m0_, h_; chunk_coords((ci), m0_, h_); const int mat_ = w >> 2, tb_ = w & 3; \
        const GAS bf16* lp_ = LL + (size_t)(m0_ + 16 * tb_) * 256 + mat_ * 64; const GAS bf16* wp_ = WL + (size_t)(mat_ * 1024 + h_ * 64) * 256 + mat_ * 64; const unsigned vo_ = (unsigned)(fr_ * 256 + 8 * fq_) * 2u; \
        _Pragma("unroll") for (int ks = 0; ks < 2; ++ks) { lfa[ks] = ldg_v4(lp_ + 32 * ks, vo_); \
            _Pragma("unroll") for (int cb = 0; cb < 4; ++cb) lfw[cb * 2 + ks] = ldg_v4(wp_ + 32 * ks, vo_ + (unsigned)(cb * 16 * 256 * 2)); } } while (0)
#define LORA_COMPUTE(ci) do { const int lane = launder_v(lane0), fr_ = lane & 15, fq_ = lane >> 4; int m0_, h_; chunk_coords((ci), m0_, h_); const int mat_ = w >> 2, tb_ = w & 3; (void)m0_; \
        const LAS float* bp_ = BIAS + mat_ * 1024 + h_ * 64 + 4 * fq_; LAS float* st_ = (mat_ ? STA : STW) + (16 * tb_ + fr_) * XP + 4 * fq_; const float sc_ = mat_ ? 1.0f : -0.60653065971263342f; \
        _Pragma("unroll") for (int cb = 0; cb < 4; ++cb) { f32x4 acc_ = {0.f, 0.f, 0.f, 0.f}; \
            _Pragma("unroll") for (int ks = 0; ks < 2; ++ks) acc_ = mma16(__builtin_bit_cast(bf16x8, lfw[cb * 2 + ks]), __builtin_bit_cast(bf16x8, lfa[ks]), acc_);     \
            const f32x4 bv_ = *(const LAS f32x4*)(bp_ + 16 * cb); \
            _Pragma("unroll") for (int j = 0; j < 4; ++j) acc_[j] = sc_ * pg8::sigmoidf_(acc_[j] + bv_[j]); \
            *(LAS f32x4*)(st_ + 16 * cb) = acc_; } } while (0)
#define SCAN1_LOAD(ci) do { const int lane = launder_v(lane0); int m0_, h_; chunk_coords((ci), m0_, h_); \
        const GAS bf16* vp_ = RKV + (size_t)(m0_ + 8 * w) * 3072 + 2048 + h_ * 64; const GAS bf16* pp_ = PJ + (size_t)(m0_ + 8 * w) * DIN + OFF_R + h_ * 64; \
        const bool samp_ = (ci) >= BP * NH * 64; const bool first_ = (w == 0) && (samp_ || ((ci) & 63) == 0);              \
        const GAS bf16* pv_ = first_ ? PJ + (size_t)(M + (((ci) - BP * NH * 64) >> 4)) * DIN + OFF_R + h_ * 64 : pp_ - DIN;     \
        const unsigned vo_ = (unsigned)lane * 2u; \
        if (first_ && !samp_) { rpw = 0u; kpw = 0u; } else { rpw = ldg_u16(pv_, vo_); kpw = ldg_u16(pv_ + 1024, vo_); } \
        _Pragma("unroll") for (int i = 0; i < 8; ++i) { \
            const unsigned vi_ = vo_ + (unsigned)(i * DIN * 2); rvw[i] = ldg_u16(pp_, vi_); kvw[i] = ldg_u16(pp_ + 1024, vi_); vvw[i] = ldg_u16(vp_, vo_ + (unsigned)(i * 3072 * 2)); } } while (0)
    LORA_LOAD((int)blockIdx.x); SCAN1_LOAD((int)blockIdx.x);
    lds_barrier();
    LORA_COMPUTE((int)blockIdx.x);
    lds_barrier();
    for (int cidx = (int)blockIdx.x; cidx < NCHUNK; cidx += G) {
        int m0, h; chunk_coords(cidx, m0, h);
        float khv[8], bhv[8], rv[8], kv[8], vv[8], av[8], lwv[8];
#pragma unroll
        for (int i = 0; i < 8; ++i) { rv[i] = __builtin_bit_cast(float, rvw[i] << 16); kv[i] = __builtin_bit_cast(float, kvw[i] << 16); vv[i] = __builtin_bit_cast(float, vvw[i] << 16); }
        float rprev = __builtin_bit_cast(float, rpw << 16), kprev = __builtin_bit_cast(float, kpw << 16);
        { const int lane = launder_v(lane0);
#pragma unroll
          for (int i = 0; i < 8; ++i) { lwv[i] = STW[(8 * w + i) * XP + lane]; av[i] = STA[(8 * w + i) * XP + lane]; } }
        {   STAGE_LANE; const int col = h * 64 + lane;
        const unsigned vo4 = (unsigned)lane * 4u; const float kkc = ldg_f32(k_k + h * 64, vo4), kac = ldg_f32(k_a + h * 64, vo4), rkc = ldg_f32(r_k + h * 64, vo4), mur = ldg_f32(mu_ + h * 64, vo4), muk = ldg_f32(mu_ + 1024 + h * 64, vo4); (void)col;
#pragma unroll
        for (int i = 0; i < 8; ++i) { const float rc = rv[i], kc = kv[i]; rv[i] = rc + mur * (rprev - rc); kv[i] = kc + muk * (kprev - kc); rprev = rc; kprev = kc; }
        float pre[8]; { float run = 0.f;
#pragma unroll
            for (int i = 0; i < 8; ++i) { run += lwv[i]; pre[i] = run; }
            GT[w * 64 + lane] = run; }
        float kkrv[8], kpv[8];
        { LAS float* S1 = STW + 8 * w * XP + lane; LAS float* S2 = STA + 8 * w * XP + lane;
#pragma unroll
          for (int i = 0; i < 8; ++i) { kkrv[i] = kv[i] * kkc; kpv[i] = kv[i] * (1.0f + (av[i] - 1.0f) * kac); S1[i * XP] = kkrv[i] * kkrv[i]; S2[i * XP] = rv[i] * kpv[i] * rkc; } }
        lds_barrier();
        float offs = 0.f, tot = 0.f;
#pragma unroll
        for (int g = 0; g < 8; ++g) { const float x = GT[g * 64 + lane]; const float sel = (g < w) ? 1.f : 0.f; tot += x; offs = fmaf(x, sel, offs); }
        float t1, t2;
        { const LAS float* S1 = STW + (8 * w + (lane >> 3)) * XP + 8 * (lane & 7); const LAS float* S2 = STA + (8 * w + (lane >> 3)) * XP + 8 * (lane & 7);
          const f32x4 a0 = *(const LAS f32x4*)S1, a1 = *(const LAS f32x4*)(S1 + 4), b0 = *(const LAS f32x4*)S2, b1 = *(const LAS f32x4*)(S2 + 4);
          t1 = sum8(((a0[0] + a0[1]) + (a0[2] + a0[3])) + ((a1[0] + a1[1]) + (a1[2] + a1[3]))); t2 = sum8(((b0[0] + b0[1]) + (b0[2] + b0[3])) + ((b1[0] + b1[1]) + (b1[2] + b1[3]))); }
        if ((lane & 7) == 0) BON[(size_t)(m0 + 8 * w + (lane >> 3)) * NH + h] = t2;
        const float etot = __expf(tot);
#pragma unroll
        for (int i = 0; i < 8; ++i) { const int t = 8 * w + i;
            const float ss = __builtin_bit_cast(float, __builtin_amdgcn_readlane(__builtin_bit_cast(int, t1), 8 * i)), kk = kkrv[i] * __builtin_amdgcn_rsqf(fmaxf(ss, 1e-24f));
            const float kp = kpv[i], bb = kk * av[i];
            const float cs = offs + pre[i], e_in = __expf(cs), e_ng = __builtin_amdgcn_rcpf(e_in), e_ex = __expf(cs - lwv[i]), e_h = etot * e_ng;
            QK[t * CP + lane] = (bf16)f2bf(kk * e_ex); RT[t * CP + lane] = (bf16)f2bf(rv[i] * e_in); KT[t * CP + lane] = (bf16)f2bf(kp * e_ng); BT[t * CP + lane] = (bf16)f2bf(bb * e_ng);
            khv[i] = kp * e_h; bhv[i] = bb * e_h; }
        { STAGE_LANE; *(LAS v4u*)(KHT + lane * CP + 8 * w) = pack8(khv); *(LAS v4u*)(BHT + lane * CP + 8 * w) = pack8(bhv); *(LAS v4u*)(VT + lane * CP + 8 * w) = pack8(vv); }
        if (w == 0) WC[lane] = etot;
        }
        if (cidx + G < NCHUNK) SCAN1_LOAD(cidx + G);
        lds_barrier();
        {   STAGE_LANE; bf16x8 aq[2], ar[2];
#pragma unroll
            for (int ks = 0; ks < 2; ++ks) { aq[ks] = frag(QK, tm, ks, lane); ar[ks] = frag(RT, tm, ks, lane); }
#pragma unroll
            for (int q = 0; q < 2; ++q) { const int tn = tn0 + q;
                const int t = 16 * tm + fr, s0 = 16 * tn + 4 * fq;
                if (tn > tm) {
                    const v2u z2 = {0u, 0u};
                    *(LAS v2u*)(AKK + t * CP + s0) = z2; *(LAS v2u*)(ARK + t * CP + s0) = z2; *(LAS v2u*)(ARB + t * CP + s0) = z2; *(LAS v2u*)(LB + t * CP + s0) = z2;
                    continue; }
                f32x4 aL = {0.f, 0.f, 0.f, 0.f}, aKK = aL, aRK = aL, aRB = aL;
#pragma unroll
                for (int ks = 0; ks < 2; ++ks) { const bf16x8 bb = frag(BT, tn, ks, lane), bk = frag(KT, tn, ks, lane);
                    aL = mma16(bb, aq[ks], aL); aKK = mma16(bk, aq[ks], aKK); aRK = mma16(bk, ar[ks], aRK); aRB = mma16(bb, ar[ks], aRB); }
                if (tn < tm) {
                    *(LAS v2u*)(AKK + t * CP + s0) = pack4(aKK); *(LAS v2u*)(ARK + t * CP + s0) = pack4(aRK); *(LAS v2u*)(ARB + t * CP + s0) = pack4(aRB); *(LAS v2u*)(LB + t * CP + s0) = pack4(aL);
                } else {
                    f32x4 mKK, mRK, mRB, mD;
#pragma unroll
                    for (int r = 0; r < 4; ++r) { const int sI = s0 + r; const bool lt = sI < t, le = sI <= t;
                        mKK[r] = lt ? aKK[r] : 0.f; mRK[r] = le ? aRK[r] : 0.f; mRB[r] = le ? aRB[r] : 0.f; mD[r] = lt ? aL[r] : 0.f; }
                    *(LAS v2u*)(AKK + t * CP + s0) = pack4(mKK); *(LAS v2u*)(ARK + t * CP + s0) = pack4(mRK); *(LAS v2u*)(ARB + t * CP + s0) = pack4(mRB); *(LAS v2u*)(LB + t * CP + s0) = (v2u){0u, 0u};
                    *(LAS f32x4*)(LD + (tm * 16 + fr) * 16 + 4 * fq) = mD; } }
        }
        lds_barrier();
        {   STAGE_LANE; bf16x8 a_[2];
#pragma unroll
            for (int ks = 0; ks < 2; ++ks) a_[ks] = frag(AKK, tm, ks, lane);
#pragma unroll
            for (int q = 0; q < 2; ++q) { const int tn = tn0 + q; f32x4 acc = {0.f, 0.f, 0.f, 0.f};
#pragma unroll
                for (int ks = 0; ks < 2; ++ks) acc = mma16(frag(VT, tn, ks, lane), a_[ks], acc);
                *(LAS f32x4*)(XF + (16 * tm + fr) * XP + 16 * tn + 4 * fq) = acc; }
            if (w == 0) { const int bb = lane >> 4, cc = lane & 15; float x[16];
                f32x4 Lr[16][4];
#pragma unroll
                for (int t = 1; t < 16; ++t)
#pragma unroll
                    for (int q4 = 0; q4 < (t + 3) / 4; ++q4) Lr[t][q4] = *(const LAS f32x4*)(LD + (bb * 16 + t) * 16 + 4 * q4);
#pragma unroll
                for (int t = 0; t < 16; ++t) { float acc = (t == cc) ? 1.f : 0.f;
#pragma unroll
                    for (int sI = 0; sI < t; ++sI) acc -= Lr[t][sI >> 2][sI & 3] * x[sI];
                    x[t] = acc; }
#pragma unroll
                for (int t = 0; t < 16; ++t) TBt[(bb * 16 + t) * TBP + cc] = (bf16)f2bf(x[t]); }
        }
        lds_barrier();
        if (cidx + G < NCHUNK) LORA_LOAD(cidx + G);
        {   STAGE_LANE; unsigned zz = 0u; asm volatile("" : "+v"(zz));
            for (int i = lane; i < 16 * CP * 2 / 16; i += 64) ((LAS v4u*)(PT + 16 * w * CP))[i] = (v4u){zz, zz, zz, zz};
            if (lane < 32) *(LAS v4u*)(ACCT + (16 * w + (lane >> 1)) * ATP + 16 + 8 * (lane & 1)) = (v4u){zz, zz, zz, zz}; asm volatile("" ::: "memory");
#pragma unroll
            for (int i = 0; i < 4; ++i) {
                f32x4 acc = {0.f, 0.f, 0.f, 0.f};
#pragma unroll
                for (int ks = 0; ks < (i + 1) / 2; ++ks) acc = mma16(frag(PT, w, ks, lane), frag(LB, i, ks, lane), acc);
                const int c0 = 16 * w + 4 * fq;
                f32x4 rhs;
                if (w < 4) { const v2u qv = *(const LAS v2u*)(QK + (16 * i + fr) * CP + c0); rhs = (f32x4){bf_lo(qv.x), bf_hi(qv.x), bf_lo(qv.y), bf_hi(qv.y)}; }
                else rhs = *(const LAS f32x4*)(XF + (16 * i + fr) * XP + c0 - 64);
                rhs = rhs - acc;
#pragma unroll
                for (int r = 0; r < 4; ++r) ACCT[(c0 + r) * ATP + fr] = (bf16)f2bf(rhs[r]);
                asm volatile("" ::: "memory");
                const bf16x8 ta = *(const LAS bf16x8*)(TBt + (16 * i + fr) * TBP + 8 * fq), tb = *(const LAS bf16x8*)(ACCT + (16 * w + fr) * ATP + 8 * fq);
                const f32x4 o = mma16(ta, tb, (f32x4){0.f, 0.f, 0.f, 0.f});
                *(LAS v2u*)(PT + (16 * w + fr) * CP + 16 * i + 4 * fq) = pack4(o);
                asm volatile("" ::: "memory");
            }
        }
        lds_barrier();
        if (cidx + G < NCHUNK) LORA_COMPUTE(cidx + G);
        {   STAGE_LANE; bf16x8 aRK[2], aRB[2], aPT[2], aVT[2], aU0[2];
#pragma unroll
            for (int ks = 0; ks < 2; ++ks) { aRK[ks] = frag(ARK, tm, ks, lane); aRB[ks] = frag(ARB, tm, ks, lane); aPT[ks] = frag(PT, tm, ks, lane); aVT[ks] = frag(VT, tm, ks, lane); aU0[ks] = frag(U0T, tm, ks, lane); }
#pragma unroll
            for (int q = 0; q < 2; ++q) { const int tn = tn0 + q; const f32x4 z = {0.f, 0.f, 0.f, 0.f};
                f32x4 y0a = z, y0b = z, qh = z, mc = z, nca = z, ncb = z;
#pragma unroll
                for (int ks = 0; ks < 2; ++ks) { const bf16x8 bVT = frag(VT, tn, ks, lane), bU0 = frag(U0T, tn, ks, lane), bPT = frag(PT, tn, ks, lane), bBH = frag(BHT, tn, ks, lane), bKH = frag(KHT, tn, ks, lane);
                    y0a = mma16(bVT, aRK[ks], y0a); y0b = mma16(bU0, aRB[ks], y0b); qh = mma16(bPT, aRB[ks], qh); mc = mma16(aPT[ks], bBH, mc); nca = mma16(bKH, aVT[ks], nca); ncb = mma16(bBH, aU0[ks], ncb); }
                const int row = 16 * tm + fr, c0 = 16 * tn + 4 * fq;
                GAS bf16* ob_ = RKV + (size_t)(m0 + 16 * tm) * 3072 + h * 64 + 16 * tn; const unsigned vo3_ = (unsigned)(fr * 3072 + 4 * fq) * 2u;
                stg_v2(ob_, vo3_, pack4(y0a - y0b));
                { const v2u rt = *(const LAS v2u*)(RT + row * CP + c0); const f32x4 rtf = {bf_lo(rt.x), bf_hi(rt.x), bf_lo(rt.y), bf_hi(rt.y)};
                  stg_v2(ob_ + 1024, vo3_, pack4(rtf - qh)); }
                { const int jj = 16 * tn + fr, i0m = 16 * tm + 4 * fq; const float wc = WC[jj]; f32x4 d;
#pragma unroll
                  for (int r = 0; r < 4; ++r) d[r] = ((tm == tn && 4 * fq + r == fr) ? wc : 0.f) - mc[r];
                  stg_v2((GAS bf16*)WD + (size_t)(m0 + 16 * tn) * 2048 + h * 128 + 16 * tm, (unsigned)(fr * 2048 + 4 * fq) * 2u, pack4(d)); }
                stg_v2(AA + (size_t)(m0 + 16 * tm) * DC + h * 64 + 16 * tn, (unsigned)(fr * DC + 4 * fq) * 2u, pack4(nca - ncb)); }
        }
        lds_barrier();
    }
#undef LORA_LOAD
#undef LORA_COMPUTE
}

__device__ __forceinline__ void phase_scan2(Frame& F, int l) {
    const kptr_t ka = kargs(); const int lane = lane_id_asm(), tid = F.wave * 64 + lane; (void)ka;
    unsigned char* const ws_ = launder_s(F.ws); float* const out_ = launder_s(F.out);
    LAS bf16* MT = launder_l((LAS bf16*)(F.lds + RING_OFF));
    LAS float* NB = (LAS float*)(MT + 2 * 64 * CP);
    LAS bf16* SH = (LAS bf16*)(NB + 2 * 1024);
    LAS bf16* SL = SH + 16 * CP;
    const GAS bf16* WDb = (const GAS bf16*)(ws_ + WS_WD); const GAS bf16* AAb = (const GAS bf16*)(ws_ + WS_AA); GAS bf16* SC = (GAS bf16*)(ws_ + WS_HB);
    const int G = F.G, w = F.wave, fr = lane & 15, fq = lane >> 4;
    const int mrow = tid >> 3, mc8 = (tid & 7) * 8;
    constexpr int NPI = BP * NH * 4, NSI = BS * NH * 4;
    for (int item = F.vcu; item < NPI + NSI; item += G) {
        const bool samp = item >= NPI; const int q = samp ? item - NPI : item, seq = q >> 2, rq = q & 3, b = seq >> 4, h = seq & 15;
        const int nch = samp ? 1 : TP / 64, cidx0 = samp ? BP * NH * 64 + seq : seq * 64, m0 = samp ? MP + b * TS : b * TP;
        f32x4 sD = {0.f, 0.f, 0.f, 0.f};
        if (samp && w < 4) { const GAS float* sp = (const GAS float*)(INP(4) + ((((size_t)l * BS + b) * NH + h) * HD + rq * 16 + 4 * fq) * HD + 16 * w + fr);
#pragma unroll
            for (int r = 0; r < 4; ++r) sD[r] = sp[r * 64]; }
#define S2_SPLIT() do { if (w < 4) { _Pragma("unroll") for (int r = 0; r < 4; ++r) { const unsigned hb = f2bf(sD[r]); const float lo = sD[r] - bf_lo(hb); \
            SH[(4 * fq + r) * CP + 16 * w + fr] = (bf16)hb; SL[(4 * fq + r) * CP + 16 * w + fr] = (bf16)f2bf(lo); } } } while (0)
        S2_SPLIT();
        v4u am, an, bm, bn, cm, cn, dm, dn;
#define S2_LOAD(st, M_, N_) do { if ((st) < nch) { const size_t mb_ = (size_t)(m0 + (st) * 64); \
            M_ = *(const GAS v4u*)(WDb + (mb_ + mrow) * 2048 + h * 128 + mc8); \
            if (tid < 128) N_ = *(const GAS v4u*)(AAb + (mb_ + rq * 16 + mrow) * DC + h * 64 + mc8); } } while (0)
#define S2_STORE(buf, M_, N_) do { *(LAS v4u*)(MT + (buf) * 64 * CP + mrow * CP + mc8) = M_; \
            if (tid < 128) { LAS float* np_ = NB + (buf) * 1024 + mrow * 64 + mc8; \
                *(LAS f32x4*)np_ = (f32x4){bf_lo(N_.x), bf_hi(N_.x), bf_lo(N_.y), bf_hi(N_.y)}; *(LAS f32x4*)(np_ + 4) = (f32x4){bf_lo(N_.z), bf_hi(N_.z), bf_lo(N_.w), bf_hi(N_.w)}; } } while (0)
        S2_LOAD(0, am, an); S2_LOAD(1, bm, bn); S2_LOAD(2, cm, cn); S2_LOAD(3, dm, dn);
        S2_STORE(0, am, an);
        S2_LOAD(4, am, an);
        lds_barrier();
#define S2_STEP(c, M_, N_) do { \
            if ((c) + 1 < nch) S2_STORE(((c) + 1) & 1, M_, N_); \
            S2_LOAD((c) + 5, M_, N_); \
            if (w < 4) { GAS bf16* scp = SC + ((size_t)(cidx0 + (c)) * 64 + rq * 16 + 4 * fq) * 64 + 16 * w + fr; \
                _Pragma("unroll") for (int r = 0; r < 4; ++r) scp[r * 64] = (bf16)f2bf(sD[r]); \
                const LAS bf16* Mt = MT + ((c) & 1) * 64 * CP; const LAS float* Nc = NB + ((c) & 1) * 1024; \
                f32x4 acc; _Pragma("unroll") for (int r = 0; r < 4; ++r) acc[r] = Nc[(4 * fq + r) * 64 + 16 * w + fr]; \
                _Pragma("unroll") for (int ks = 0; ks < 2; ++ks) { const bf16x8 bm_ = frag(Mt, w, ks, lane); \
                    acc = mma16(frag(SH, 0, ks, lane), bm_, acc); acc = mma16(frag(SL, 0, ks, lane), bm_, acc); } \
                sD = acc; } \
            lds_barrier(); \
            S2_SPLIT(); \
            lds_barrier(); } while (0)
        for (int c = 0; c < nch; c += 4) {
            S2_STEP(c, bm, bn); if (c + 1 >= nch) break;
            S2_STEP(c + 1, cm, cn); if (c + 2 >= nch) break;
            S2_STEP(c + 2, dm, dn); if (c + 3 >= nch) break;
            S2_STEP(c + 3, am, an);
        }
#undef S2_STEP
#undef S2_LOAD
#undef S2_STORE
#undef S2_SPLIT
        if (w < 4) { GAS float* so = (GAS float*)out_ + (samp ? O_WKVS + ((((size_t)l * BS + b) * NH + h) * HD + rq * 16 + 4 * fq) * HD : O_WKVP + ((((size_t)l * BP + b) * NH + h) * HD + rq * 16 + 4 * fq) * HD) + 16 * w + fr;
#pragma unroll
            for (int r = 0; r < 4; ++r) so[r * 64] = sD[r]; }
    }
}

__device__ __forceinline__ void phase_scan3(Frame& F, int l) {
    const kptr_t ka = kargs(); const int lane = lane_id_asm(), tid = F.wave * 64 + lane; (void)ka;
    unsigned char* const ws_ = launder_s(F.ws);
    LAS bf16* QH = launder_l((LAS bf16*)(F.lds + RING_OFF)); LAS bf16* SCB = QH + 64 * CP; LAS float* YF = (LAS float*)(QH + 2 * 64 * CP); constexpr int YP = 68;
    const GAS bf16* RKV = (const GAS bf16*)(ws_ + WS_RKV); const GAS bf16* SC = (const GAS bf16*)(ws_ + WS_HB); const GAS float* BON = (const GAS float*)(ws_ + WS_GG);
    const GAS bf16* LL = (const GAS bf16*)(ws_ + WS_LL); const GAS bf16* WL = (const GAS bf16*)(ws_ + WS_WLORA + (size_t)l * SZ_WLORA);
    constexpr int GP = 136; LAS bf16* XG = (LAS bf16*)(YF + 64 * 68); LAS bf16* WG = XG + 64 * GP; LAS float* GF = (LAS float*)(WG + 64 * GP);
    GAS bf16* ARWKV = (GAS bf16*)(ws_ + WS_ARWKV);
    const GAS float* lnw = (const GAS float*)(INP(17) + (size_t)l * DC); const GAS float* lnb = (const GAS float*)(INP(18) + (size_t)l * DC);
    const int w = F.wave, G = F.G, tok = tid >> 3, sg = tid & 7, tm = w >> 1, tn0 = (w & 1) * 2, fr = lane & 15, fq = lane >> 4;
    v4u pqh, psc, py0, pv, pl0, pl1, pw0, pw1; float pbon;
#define S3_LOAD(ci) do { int m0_, h_; chunk_coords((ci), m0_, h_); const size_t m_ = (size_t)(m0_ + tok); const int col_ = h_ * 64 + sg * 8; \
        pqh = *(const GAS v4u*)(RKV + m_ * 3072 + 1024 + col_); psc = *(const GAS v4u*)(SC + ((size_t)(ci) * 64 + tok) * 64 + sg * 8); \
        py0 = *(const GAS v4u*)(RKV + m_ * 3072 + col_); pv = *(const GAS v4u*)(RKV + m_ * 3072 + 2048 + col_); pbon = BON[m_ * NH + h_]; \
        { const int r0_ = tid >> 4, k8_ = (tid & 15) * 8; const GAS bf16* lp_ = LL + (size_t)(m0_ + r0_) * 256 + 128 + k8_; const GAS bf16* wp_ = WL + (size_t)(2048 + h_ * 64 + r0_) * 256 + 128 + k8_; \
          pl0 = *(const GAS v4u*)lp_; pl1 = *(const GAS v4u*)(lp_ + 32 * 256); pw0 = *(const GAS v4u*)wp_; pw1 = *(const GAS v4u*)(wp_ + 32 * 256); } } while (0)
    if ((int)blockIdx.x < NCHUNK) S3_LOAD((int)blockIdx.x);
    for (int cidx = (int)blockIdx.x; cidx < NCHUNK; cidx += G) {
        int m0, h; chunk_coords(cidx, m0, h);
        const size_t m = (size_t)(m0 + tok); const int col = h * 64 + sg * 8;
        *(LAS v4u*)(QH + tok * CP + sg * 8) = pqh; *(LAS v4u*)(SCB + tok * CP + sg * 8) = psc;
        { const int r0 = tid >> 4, k8 = (tid & 15) * 8; *(LAS v4u*)(XG + r0 * GP + k8) = pl0; *(LAS v4u*)(XG + (r0 + 32) * GP + k8) = pl1; *(LAS v4u*)(WG + r0 * GP + k8) = pw0; *(LAS v4u*)(WG + (r0 + 32) * GP + k8) = pw1; }
        const v4u y0w = py0, vw = pv; const float bon = pbon;
        const f32x4 lw0 = *(const GAS f32x4*)(lnw + col), lw1 = *(const GAS f32x4*)(lnw + col + 4), lb0 = *(const GAS f32x4*)(lnb + col), lb1 = *(const GAS f32x4*)(lnb + col + 4);
        lds_barrier();
        if (cidx + G < NCHUNK) S3_LOAD(cidx + G);
        {   bf16x8 a_[2];
#pragma unroll
            for (int ks = 0; ks < 2; ++ks) a_[ks] = frag(QH, tm, ks, lane);
#pragma unroll
            for (int q = 0; q < 2; ++q) { const int tn = tn0 + q; f32x4 acc = {0.f, 0.f, 0.f, 0.f};
#pragma unroll
                for (int ks = 0; ks < 2; ++ks) acc = mma16(frag(SCB, tn, ks, lane), a_[ks], acc);
                *(LAS f32x4*)(YF + (16 * tm + fr) * YP + 16 * tn + 4 * fq) = acc; }
            bf16x8 x_[4];
#pragma unroll
            for (int ks = 0; ks < 4; ++ks) x_[ks] = *(const LAS bf16x8*)(XG + (16 * tm + fr) * GP + 32 * ks + 8 * fq);
#pragma unroll
            for (int q = 0; q < 2; ++q) { const int tn = tn0 + q; f32x4 acc = {0.f, 0.f, 0.f, 0.f};
#pragma unroll
                for (int ks = 0; ks < 4; ++ks) acc = mma16(*(const LAS bf16x8*)(WG + (16 * tn + fr) * GP + 32 * ks + 8 * fq), x_[ks], acc);
                *(LAS f32x4*)(GF + (16 * tm + fr) * YP + 16 * tn + 4 * fq) = acc; }
        }
        lds_barrier();
        {   float y[8], y0[8], vv[8], g[8], ov[8]; unpack8(y0w, y0); unpack8(vw, vv);
            { const f32x4 ga = *(const LAS f32x4*)(GF + tok * YP + sg * 8), gb = *(const LAS f32x4*)(GF + tok * YP + sg * 8 + 4); g[0] = ga[0]; g[1] = ga[1]; g[2] = ga[2]; g[3] = ga[3]; g[4] = gb[0]; g[5] = gb[1]; g[6] = gb[2]; g[7] = gb[3]; }
            const f32x4 ya = *(const LAS f32x4*)(YF + tok * YP + sg * 8), yb = *(const LAS f32x4*)(YF + tok * YP + sg * 8 + 4);
            y[0] = ya[0] + y0[0]; y[1] = ya[1] + y0[1]; y[2] = ya[2] + y0[2]; y[3] = ya[3] + y0[3]; y[4] = yb[0] + y0[4]; y[5] = yb[1] + y0[5]; y[6] = yb[2] + y0[6]; y[7] = yb[3] + y0[7];
            float s_ = 0.f;
#pragma unroll
            for (int j = 0; j < 8; ++j) s_ += y[j];
            const float mean = sum8(s_) * (1.f / 64.f); float qv = 0.f;
#pragma unroll
            for (int j = 0; j < 8; ++j) { y[j] -= mean; qv += y[j] * y[j]; }
            const float rstd = __builtin_amdgcn_rsqf(sum8(qv) * (1.f / 64.f) + GN_EPS);
#pragma unroll
            for (int j = 0; j < 8; ++j) { const float lw_ = (j < 4) ? lw0[j & 3] : lw1[j & 3], lb_ = (j < 4) ? lb0[j & 3] : lb1[j & 3]; ov[j] = (y[j] * rstd * lw_ + lb_ + bon * vv[j]) * g[j]; }
            *(GAS v4u*)(ARWKV + m * DC + col) = pack8(ov);
        }
        lds_barrier();
    }
#undef S3_LOAD
}

constexpr int NPH = 12;
constexpr int NSTEPS = 1 + NL * NPH + 1;
__global__ void __launch_bounds__(NWAVES * 64, 2) trunk_fwd(Args args) {
    extern __shared__ __attribute__((aligned(16))) unsigned char lds[];
    Frame F;
    F.lds = (LAS unsigned char*)lds;
    F.wave = __builtin_amdgcn_readfirstlane((int)threadIdx.x >> 6);
    F.G = gridDim.x; { const int bx = blockIdx.x; F.vcu = launder_si((F.G % 8 == 0) ? (bx % 8) * (F.G / 8) + bx / 8 : bx); }
    F.out = args.out; F.ws = args.ws;
    volatile LAS unsigned* MISC = (volatile LAS unsigned*)(F.lds + MISC_OFF);
    for (int u = threadIdx.x; u < (LDS_BYTES - LDSCTL_OFF) / 4; u += NWAVES * 64) ((LAS unsigned*)(F.lds + LDSCTL_OFF))[u] = 0u;
    __syncthreads();
    const int lo = args.st_lo, hi = args.st_hi;
    const bool use_bar = (hi - lo) > 1;
    unsigned* barw = (unsigned*)(F.ws + WS_CTL) + CW_BAR;
    XcdBarrier bar; bar.bar = barw; bar.x = 0; bar.st = nullptr; bar.wave = F.wave;
    if (use_bar) bar = xcd_barrier_post(barw, MISC + 8, F.wave);
#define IN(k) (lo <= (k) && (k) < hi)
#define SEAM(k) do { if (IN(k) && IN((k) + 1)) xcd_barrier(bar); } while (0)
    PG8_LAS unsigned char* ring = F.lds + RING_OFF;
    const int bx = (int)blockIdx.x;

    if (IN(0)) { phase_prologue(F); }
#define WSL const int l = launder_si(lq); unsigned char* ws = launder_s(F.ws); bf16* HB = (bf16*)(ws + WS_HB); bf16* PU = (bf16*)(ws + WS_PU); bf16* Z = (bf16*)(ws + WS_RKV); (void)HB; (void)PU; (void)Z
    for (int lq = 0; lq < NL; ++lq) {
        const int s0 = 1 + lq * NPH;
        if (IN(s0 + 0)) phase_norm(F, launder_si(lq), 0);
        SEAM(s0 + 0);
        if (IN(s0 + 1)) { WSL; pg8::Gemm g{HB, (const bf16*)(ws + WS_WIN + l * SZ_WIN), MA, DIN, D}; pg8::Order S; S.init(M / 256, DIN / 256, F.G, bx, D, 13, OFF_R / 256);
            pg8::EpiBf16 E{(GAS bf16*)PU, DIN, 0}; pg8::gemm_phase<pg8::EpiBf16, pg8::Order, true, true>(ring, g, S, E, F.wave); }
        SEAM(s0 + 1);
        if (IN(s0 + 2)) phase_mix(F, launder_si(lq));
        SEAM(s0 + 2);
        if (IN(s0 + 3)) phase_scan1(F, launder_si(lq));
        SEAM(s0 + 3);
        if (IN(s0 + 4)) phase_scan2(F, launder_si(lq));
        SEAM(s0 + 4);
        if (IN(s0 + 5)) phase_scan3(F, launder_si(lq));
        SEAM(s0 + 5);
        if (IN(s0 + 6)) { WSL; pg8::Gemm g{(const bf16*)(ws + WS_ACONV), (const bf16*)(ws + WS_WOC + l * SZ_WOC), M, D, DC}; pg8::Order S; S.init(MP / 256, D / 256, F.G, bx, DC, (MS / 256) * (D / 256) * 4, 0, 4, 4, 0);
            pg8::EpiGate E{(GAS bf16*)Z, (const GAS bf16*)(PU + OFF_GC), DIN, 0, (GAS bf16*)(ws + WS_WD), MP}; pg8::gemm_phase<pg8::EpiGate, pg8::Order, true, true>(ring, g, S, E, F.wave); }
        if (IN(s0 + 6)) { WSL; pg8::Gemm g{(const bf16*)(ws + WS_ARWKV), (const bf16*)(ws + WS_WOR + l * SZ_WOC), M, D, DC}; pg8::Order S; S.init(MP / 256, D / 256, F.G, bx, DC, (MS / 256) * (D / 256) * 4, 0, 4, 4, F.G / 2);
            pg8::EpiGate E{(GAS bf16*)Z, (const GAS bf16*)(PU + OFF_GR), DIN, 1, (GAS bf16*)(ws + WS_AA), MP}; pg8::gemm_phase<pg8::EpiGate, pg8::Order, true, true>(ring, g, S, E, F.wave); }
        SEAM(s0 + 6);
        if (IN(s0 + 7)) phase_zred(F);
        SEAM(s0 + 7);
        if (IN(s0 + 8)) { WSL; pg8::Gemm g{Z, (const bf16*)(ws + WS_WO + l * SZ_WO), M, D, D}; pg8::Order S; S.init(MP / 256, D / 256, F.G, bx, D, (MS / 256) * (D / 256) * 8, 0, 8);
            GAS bf16* XB = (GAS bf16*)launder_s(F.out); pg8::EpiRes E{XB, XB, D, (GAS bf16*)(ws + WS_WD), MP}; pg8::gemm_phase<pg8::EpiRes, pg8::Order, true, true>(ring, g, S, E, F.wave); }
        SEAM(s0 + 8);
        if (IN(s0 + 9)) phase_norm(F, launder_si(lq), 1);
        SEAM(s0 + 9);
        if (IN(s0 + 10)) { WSL; pg8::Gemm g{HB, (const bf16*)(ws + WS_WUP + l * SZ_WUP), M, DFF, D}; pg8::Order S; S.init(M / 256, DFF / 256, F.G, bx, D);
            pg8::EpiBf16 E{(GAS bf16*)PU, DFF, 1}; pg8::gemm_phase<pg8::EpiBf16, pg8::Order, true, true>(ring, g, S, E, F.wave); }
        SEAM(s0 + 10);
        if (IN(s0 + 11)) { WSL; pg8::Gemm g{PU, (const bf16*)(ws + WS_WDN + l * SZ_WUP), M, D, DFF}; pg8::Order S; S.init(MP / 256, D / 256, F.G, bx, DFF, (MS / 256) * (D / 256) * 8, 0, 8);
            GAS bf16* XB = (GAS bf16*)launder_s(F.out); GAS bf16* XO = (l == NL - 1) ? (GAS bf16*)(ws + WS_RKV) : XB;
            pg8::EpiRes E{XB, XO, D, (GAS bf16*)(ws + WS_WD), MP}; pg8::gemm_phase<pg8::EpiRes, pg8::Order, true, true>(ring, g, S, E, F.wave); }
        SEAM(s0 + 11);
    }
    { const int lo2 = launder_si(lo), hi2 = launder_si(hi); if (lo2 <= NSTEPS - 1 && NSTEPS - 1 < hi2) phase_norm(F, 0, 2); }
#undef IN
#undef SEAM
}

extern "C" void kernel_launch(void* const* d_in, const int* in_sizes, int n_in, void* d_out, int out_size, void* d_ws, size_t ws_size, hipStream_t stream) {
    static int grid = 0;
    if (grid == 0) {
        if (n_in != 26 || (size_t)out_size != O_END || ws_size < WS_END) { fprintf(stderr, "kernel_launch: shape mismatch n_in %d out %d ws %zu (need %zu)\n", n_in, out_size, ws_size, (size_t)WS_END); grid = -1; return; }
        int dev = 0, cus = 0, per_cu = 0;
        if (hipGetDevice(&dev) != hipSuccess || hipDeviceGetAttribute(&cus, hipDeviceAttributeMultiprocessorCount, dev) != hipSuccess) { grid = -1; return; }
        if (hipFuncSetAttribute((const void*)trunk_fwd, hipFuncAttributeMaxDynamicSharedMemorySize, LDS_BYTES) != hipSuccess) { fprintf(stderr, "kernel_launch: hipFuncSetAttribute failed\n"); grid = -1; return; }
        if (hipOccupancyMaxActiveBlocksPerMultiprocessor(&per_cu, (const void*)trunk_fwd, NWAVES * 64, LDS_BYTES) != hipSuccess || per_cu < 1)
            fprintf(stderr, "kernel_launch: occupancy query reports %d workgroups per CU\n", per_cu);
        (void)hipGetLastError();
        grid = cus;
    }
    if (grid < 0) return;
    if (hipMemsetAsync((char*)d_ws + WS_CTL, 0, CTL_ZERO_BYTES, stream) != hipSuccess) return;
    Args a{};
    for (int i = 0; i < 26; ++i) a.in[i] = (const float*)d_in[i];
    a.out = (float*)d_out; a.ws = (unsigned char*)d_ws;
#if MK_ONE_LAUNCH
    a.st_lo = 0; a.st_hi = NSTEPS;
    hipLaunchKernelGGL(trunk_fwd, dim3(grid), dim3(NWAVES * 64), LDS_BYTES, stream, a);
#else
    for (int s = 0; s < NSTEPS; ++s) {
        a.st_lo = s; a.st_hi = s + 1;
        hipLaunchKernelGGL(trunk_fwd, dim3(grid), dim3(NWAVES * 64), LDS_BYTES, stream, a);
    }
#endif
}
```
